# Optimizing an MI355X kernel written in HIP

```python
import jax, jax.numpy as jnp
from jax import lax
import numpy as np

D_MODEL = 2048
BATCH = 4
SEQ = 4096
DEPTH = 2

HEAD_DIM = 128
N_SB_HEADS = D_MODEL // (2 * HEAD_DIM)
N_FOX_HEADS = D_MODEL // (2 * HEAD_DIM)
SB_WIDTH = N_SB_HEADS * HEAD_DIM
FOX_WIDTH = N_FOX_HEADS * HEAD_DIM
IN_WIDTH = 3 * SB_WIDTH + 3 * FOX_WIDTH + N_FOX_HEADS

N_MLA_HEADS = 16
Q_LORA_RANK = 512
KV_LORA_RANK = 512
QK_NOPE_DIM = 128
QK_ROPE_DIM = 64
QK_HEAD_DIM = QK_NOPE_DIM + QK_ROPE_DIM
V_HEAD_DIM = 128
DOWN_WIDTH = Q_LORA_RANK + KV_LORA_RANK + QK_ROPE_DIM

D_FF = 4 * D_MODEL
BLOCK_Q = 128
ROPE_THETA = 10000.0
EPS = 1e-6
FORGET_BIAS_CENTER = 3.0

N_EVEN = (DEPTH + 1) // 2
N_ODD = DEPTH // 2

kernel_name = "hybrid_stickbreak_fox_mla_sqrelu"


def rmsnorm(x, g):
    x32 = x.astype(jnp.float32)
    y = x32 * lax.rsqrt(jnp.mean(x32 * x32, axis=-1, keepdims=True) + EPS)
    return (y * g.astype(jnp.float32)).astype(x.dtype)


def to_heads(t, n_heads):
    b, s, _ = t.shape
    return t.reshape(b, s, n_heads, -1).transpose(0, 2, 1, 3)


def query_blocks(q):
    b, h, s, d = q.shape
    return q.reshape(b, h, s // BLOCK_Q, BLOCK_Q, d).transpose(2, 0, 1, 3, 4)


def merge_blocks(o):
    nb, b, h, bq, d = o.shape
    return o.transpose(1, 0, 3, 2, 4).reshape(b, nb * bq, h * d)


def stick_breaking_attention(q, k, v):
    s = q.shape[2]
    scale = q.shape[-1] ** -0.5
    key_pos = jnp.arange(s)

    def one_block(args):
        qb, q0 = args
        z = jnp.einsum('bhqd,bhkd->bhqk', qb, k,
                       preferred_element_type=jnp.float32) * scale
        q_pos = q0 + jnp.arange(BLOCK_Q)
        strict = key_pos[None, :] < q_pos[:, None]
        log_beta = jax.nn.log_sigmoid(z)
        log_one_minus = jnp.where(strict, jax.nn.log_sigmoid(-z), 0.0)
        suffix = lax.cumsum(log_one_minus, axis=3, reverse=True) - log_one_minus
        w = jnp.where(strict, jnp.exp(log_beta + suffix), 0.0)
        return jnp.einsum('bhqk,bhkd->bhqd', w.astype(v.dtype), v,
                          preferred_element_type=jnp.float32).astype(v.dtype)

    starts = jnp.arange(s // BLOCK_Q, dtype=jnp.int32) * BLOCK_Q
    return merge_blocks(lax.map(one_block, (query_blocks(q), starts)))


def causal_softmax_attention(q, k, v, log_decay_cum=None):
    s = q.shape[2]
    scale = q.shape[-1] ** -0.5
    key_pos = jnp.arange(s)

    def one_block(args):
        qb, q0 = args
        logits = jnp.einsum('bhqd,bhkd->bhqk', qb, k,
                            preferred_element_type=jnp.float32) * scale
        if log_decay_cum is not None:
            f_q = lax.dynamic_slice_in_dim(log_decay_cum, q0, BLOCK_Q, axis=2)
            logits = logits + f_q[..., :, None] - log_decay_cum[..., None, :]
        q_pos = q0 + jnp.arange(BLOCK_Q)
        causal = key_pos[None, :] <= q_pos[:, None]
        p = jax.nn.softmax(jnp.where(causal, logits, -jnp.inf), axis=-1)
        return jnp.einsum('bhqk,bhkd->bhqd', p.astype(v.dtype), v,
                          preferred_element_type=jnp.float32).astype(v.dtype)

    starts = jnp.arange(s // BLOCK_Q, dtype=jnp.int32) * BLOCK_Q
    return merge_blocks(lax.map(one_block, (query_blocks(q), starts)))


def apply_rope(t, positions):
    half = t.shape[-1] // 2
    inv_freq = ROPE_THETA ** (-jnp.arange(half, dtype=jnp.float32) / half)
    ang = positions.astype(jnp.float32)[:, None, :, None] * inv_freq
    cos, sin = jnp.cos(ang), jnp.sin(ang)
    t32 = t.astype(jnp.float32)
    t1, t2 = t32[..., :half], t32[..., half:]
    return jnp.concatenate([t1 * cos - t2 * sin, t2 * cos + t1 * sin], axis=-1).astype(t.dtype)


def sb_fox_mixer(h, w_in, b_f, fox_q_g, fox_k_g, w_o):
    proj = h @ w_in
    cuts = np.cumsum([SB_WIDTH] * 3 + [FOX_WIDTH] * 3)
    q_sb, k_sb, v_sb, q_fx, k_fx, v_fx, f_logit = jnp.split(proj, cuts, axis=-1)
    o_sb = stick_breaking_attention(to_heads(q_sb, N_SB_HEADS),
                                    to_heads(k_sb, N_SB_HEADS),
                                    to_heads(v_sb, N_SB_HEADS))
    log_f = jax.nn.log_sigmoid(f_logit.astype(jnp.float32) + b_f.astype(jnp.float32))
    log_f_cum = jnp.cumsum(log_f, axis=1).transpose(0, 2, 1)
    q_f = rmsnorm(to_heads(q_fx, N_FOX_HEADS), fox_q_g)
    k_f = rmsnorm(to_heads(k_fx, N_FOX_HEADS), fox_k_g)
    o_fx = causal_softmax_attention(q_f, k_f, to_heads(v_fx, N_FOX_HEADS), log_f_cum)
    return jnp.concatenate([o_sb, o_fx], axis=-1) @ w_o


def mla_mixer(h, positions, w_down, q_a_g, kv_a_g, w_uq, w_ukv, q_g, k_g, w_o):
    b, s, _ = h.shape
    down = h @ w_down
    c_q, c_kv, k_pe = jnp.split(down, [Q_LORA_RANK, Q_LORA_RANK + KV_LORA_RANK], axis=-1)
    c_q = rmsnorm(c_q, q_a_g)
    c_kv = rmsnorm(c_kv, kv_a_g)
    q = to_heads(c_q @ w_uq, N_MLA_HEADS)
    kv = to_heads(c_kv @ w_ukv, N_MLA_HEADS)
    k_nope, v = kv[..., :QK_NOPE_DIM], kv[..., QK_NOPE_DIM:]
    k_pe = jnp.broadcast_to(k_pe[:, None], (b, N_MLA_HEADS, s, QK_ROPE_DIM))
    k = jnp.concatenate([k_nope, k_pe], axis=-1)
    q = rmsnorm(q, q_g)
    k = rmsnorm(k, k_g)
    q = jnp.concatenate([q[..., :QK_NOPE_DIM], apply_rope(q[..., QK_NOPE_DIM:], positions)], axis=-1)
    k = jnp.concatenate([k[..., :QK_NOPE_DIM], apply_rope(k[..., QK_NOPE_DIM:], positions)], axis=-1)
    o = causal_softmax_attention(q, k, v)
    return o @ w_o


def squared_relu_mlp(h, w_up, w_down):
    a = jnp.square(jax.nn.relu(h @ w_up))
    return a @ w_down


def setup_inputs(seed: int = 0) -> dict:
    key = jax.random.key(seed)
    ks = jax.random.split(key, 24)

    def dense(k, shape, fan_in):
        return jax.random.normal(k, shape, jnp.float32) * (fan_in ** -0.5)

    def gain(k, shape):
        return 1.0 + 0.02 * jax.random.normal(k, shape, jnp.float32)

    x = jax.random.normal(ks[0], (BATCH, SEQ, D_MODEL), jnp.float32)
    offsets = jax.random.randint(ks[1], (BATCH, 1), 0, 2048, dtype=jnp.int32)
    positions = offsets + jnp.arange(SEQ, dtype=jnp.int32)[None, :]
    return {
        "x": x,
        "positions": positions,
        "ln_mix_g": gain(ks[2], (DEPTH, D_MODEL)),
        "ln_mlp_g": gain(ks[3], (DEPTH, D_MODEL)),
        "sf_w_in": dense(ks[4], (N_EVEN, D_MODEL, IN_WIDTH), D_MODEL),
        "sf_b_f": FORGET_BIAS_CENTER + 0.1 * jax.random.normal(ks[5], (N_EVEN, N_FOX_HEADS), jnp.float32),
        "fox_q_g": gain(ks[6], (N_EVEN, HEAD_DIM)),
        "fox_k_g": gain(ks[7], (N_EVEN, HEAD_DIM)),
        "sf_w_o": dense(ks[8], (N_EVEN, SB_WIDTH + FOX_WIDTH, D_MODEL), SB_WIDTH + FOX_WIDTH),
        "mla_w_down": dense(ks[9], (N_ODD, D_MODEL, DOWN_WIDTH), D_MODEL),
        "mla_q_a_g": gain(ks[10], (N_ODD, Q_LORA_RANK)),
        "mla_kv_a_g": gain(ks[11], (N_ODD, KV_LORA_RANK)),
        "mla_w_uq": dense(ks[12], (N_ODD, Q_LORA_RANK, N_MLA_HEADS * QK_HEAD_DIM), Q_LORA_RANK),
        "mla_w_ukv": dense(ks[13], (N_ODD, KV_LORA_RANK, N_MLA_HEADS * (QK_NOPE_DIM + V_HEAD_DIM)), KV_LORA_RANK),
        "mla_q_g": gain(ks[14], (N_ODD, QK_HEAD_DIM)),
        "mla_k_g": gain(ks[15], (N_ODD, QK_HEAD_DIM)),
        "mla_w_o": dense(ks[16], (N_ODD, N_MLA_HEADS * V_HEAD_DIM, D_MODEL), N_MLA_HEADS * V_HEAD_DIM),
        "mlp_w_up": dense(ks[17], (DEPTH, D_MODEL, D_FF), D_MODEL),
        "mlp_w_down": dense(ks[18], (DEPTH, D_FF, D_MODEL), D_FF),
    }


def reference(x, positions, ln_mix_g, ln_mlp_g, sf_w_in, sf_b_f, fox_q_g, fox_k_g, sf_w_o,
              mla_w_down, mla_q_a_g, mla_kv_a_g, mla_w_uq, mla_w_ukv, mla_q_g, mla_k_g,
              mla_w_o, mlp_w_up, mlp_w_down):
    for layer in range(DEPTH):
        i = layer // 2
        h = rmsnorm(x, ln_mix_g[layer])
        if layer % 2 == 0:
            x = x + sb_fox_mixer(h, sf_w_in[i], sf_b_f[i], fox_q_g[i], fox_k_g[i], sf_w_o[i])
        else:
            x = x + mla_mixer(h, positions, mla_w_down[i], mla_q_a_g[i], mla_kv_a_g[i],
                              mla_w_uq[i], mla_w_ukv[i], mla_q_g[i], mla_k_g[i], mla_w_o[i])
        h = rmsnorm(x, ln_mlp_g[layer])
        x = x + squared_relu_mlp(h, mlp_w_up[layer], mlp_w_down[layer])
    return x
```

```cpp
#include <hip/hip_runtime.h>
#include <hip/hip_cooperative_groups.h>
#include <cstdio>
#include <cstdint>
namespace cg = cooperative_groups;

#define LAS __attribute__((address_space(3)))
#define GAS __attribute__((address_space(1)))
typedef unsigned short bf16_t;
typedef short bf16x8 __attribute__((ext_vector_type(8)));
typedef short s16x4 __attribute__((ext_vector_type(4)));
typedef float f32x4 __attribute__((ext_vector_type(4)));
typedef float f32x16 __attribute__((ext_vector_type(16)));
typedef unsigned u32x4 __attribute__((ext_vector_type(4)));
typedef unsigned u32x2 __attribute__((ext_vector_type(2)));

constexpr int NB = 4, SEQ = 4096, M = NB * SEQ, DM = 2048, DFF = 8192, INW = 6152;
constexpr float EPS = 1e-6f;
constexpr float LOG2E = 1.4426950408889634f;
constexpr size_t MiB = 1u << 20;
constexpr size_t WS_RS = 0;
constexpr size_t WS_LF = 512 * 1024, WS_F2 = 1 * MiB, WS_KPE = 2 * MiB, WS_BAR = 6 * MiB, WS_KSS0 = 6 * MiB + 512 * 1024, WS_KSS1 = 7 * MiB;
constexpr size_t WS_WIN = 8 * MiB, WS_WO0 = 32 * MiB, WS_WUP0 = 40 * MiB, WS_WDN0 = 72 * MiB;
constexpr size_t WS_CQ = 8 * MiB, WS_CKV = 24 * MiB, WS_AO1 = 40 * MiB;
constexpr size_t WS_WMD = 104 * MiB, WS_WUQ = 109 * MiB, WS_WUKV = 112 * MiB, WS_WO1 = 116 * MiB, WS_WUP1 = 124 * MiB, WS_WDN1 = 156 * MiB;
constexpr size_t WS_XB = 188 * MiB;
constexpr size_t WS_BIG = 252 * MiB;
constexpr size_t WS_Q0 = WS_BIG, WS_K0 = WS_BIG + 64 * MiB, WS_V0 = WS_BIG + 128 * MiB, WS_AO0 = WS_BIG + 192 * MiB, WS_H = WS_BIG;
constexpr size_t WS_Q1 = WS_BIG, WS_K1 = WS_BIG + 96 * MiB, WS_V1 = WS_BIG + 160 * MiB;
constexpr size_t WS_KPR = 508 * MiB, WS_SSPE = 510 * MiB;
constexpr size_t WS_END = 511 * MiB;
constexpr int LDS_BYTES = 147456;
#ifndef DUP_MASK
#define DUP_MASK 0
#endif

__device__ __forceinline__ unsigned cvt_pk_bf16(float lo, float hi) { unsigned r; asm volatile("v_cvt_pk_bf16_f32 %0, %1, %2" : "=v"(r) : "v"(lo), "v"(hi)); return r; }
__device__ __forceinline__ float bf2f(short s) { return __uint_as_float(((unsigned)(unsigned short)s) << 16); }
__device__ __forceinline__ float wave_sum(float v) {
#pragma unroll
    for (int o = 1; o < 64; o <<= 1) v += __shfl_xor(v, o);
    return v;
}

namespace pg8 {
constexpr int BM = 256, BK = 64, HALF = 128, HTB = HALF * BK * 2, STAGE_BYTES = 8 * HTB, NXCD = 8, WGM = 4;
__host__ __device__ __forceinline__ int lds_byte(int r, int c) { const int st = (r >> 4) * 2 + (c >> 5), rr = r & 15, cc = c & 31, ob = rr * 64 + cc * 2; return st * 1024 + (ob ^ (((ob >> 9) & 1) << 5)); }
__host__ __device__ __forceinline__ void stage_rc(int b, int& R, int& C) { const int st = b / 1024, sb = b % 1024, swz = sb ^ (((sb >> 9) & 1) << 5); R = (st >> 1) * 16 + swz / 64; C = (st & 1) * 32 + (swz % 64) / 2; }
__host__ __device__ __forceinline__ int perm32(int rho) { const int n = rho >> 4, i = rho & 15; return 8 * (i >> 2) + 4 * n + (i & 3); }
struct Unit { int pm, pn; };
struct Gemm { const bf16_t* A; const bf16_t* Bt; int M, N, K; };
struct StaticOrder {
    int nM, nN, nwg, G, c;
    __host__ __device__ void init(int M_, int N_, int G_, int c_) { nM = M_ / BM; nN = N_ / BM; nwg = nM * nN; G = G_; c = c_; }
    __host__ __device__ bool next(int i, Unit& u) const {
        const long L = (long)i * G + c; if (L >= nwg) return false;
        int wgid = (int)L; { const int q = nwg / NXCD, r = nwg % NXCD, xcd = wgid % NXCD, off = wgid / NXCD; wgid = (xcd < r ? xcd * (q + 1) : r * (q + 1) + (xcd - r) * q) + off; }
        const int nig = WGM * nN, gid = wgid / nig, fm = gid * WGM, gsz = (nM - fm) < WGM ? (nM - fm) : WGM;
        u.pm = fm + ((wgid % nig) % gsz); u.pn = (wgid % nig) / gsz; return true;
    }
};

enum { K_IN = 0, K_PLAIN = 1, K_UP = 2, K_UKV = 3, K_RES = 4, K_MDOWN = 5 };
struct Epi {
    static constexpr bool PERM = true;
    int kind; int last;
    bf16_t* d0; bf16_t* d1; bf16_t* d2; int ldc;
    const float* rs; float invn;
    const float* xold; float* xout; bf16_t* xb; float* rsn;
    float* kpe; float* rsq; float* rskv; float* kss;
    __device__ __forceinline__ void operator()(const f32x4 (&acc)[2][2][4][2], const Unit& u, int wr, int wc, int fr, int fq) const {
        const int row0 = u.pm * BM + wr * 64 + fr; const int lc = wc * 32 + 8 * fq;
        if (kind == K_RES) {
#pragma unroll
            for (int ai = 0; ai < 2; ++ai)
#pragma unroll
                for (int m = 0; m < 4; ++m) {
                    const int row = row0 + ai * HALF + m * 16; float ss = 0.f;
#pragma unroll
                    for (int bj = 0; bj < 2; ++bj) {
                        const size_t off = (size_t)row * DM + u.pn * BM + bj * HALF + lc;
                        const u32x4 xo = *(const GAS u32x4*)(xb + off);
                        f32x4 a = {__uint_as_float(xo.x << 16), __uint_as_float(xo.x & 0xffff0000u), __uint_as_float(xo.y << 16), __uint_as_float(xo.y & 0xffff0000u)};
                        f32x4 b = {__uint_as_float(xo.z << 16), __uint_as_float(xo.z & 0xffff0000u), __uint_as_float(xo.w << 16), __uint_as_float(xo.w & 0xffff0000u)};
                        a += acc[ai][bj][m][0]; b += acc[ai][bj][m][1];
                        if (!last) {
                            ss += (a[0] * a[0] + a[1] * a[1]) + (a[2] * a[2] + a[3] * a[3]) + (b[0] * b[0] + b[1] * b[1]) + (b[2] * b[2] + b[3] * b[3]);
                            u32x4 w; w.x = cvt_pk_bf16(a[0], a[1]); w.y = cvt_pk_bf16(a[2], a[3]); w.z = cvt_pk_bf16(b[0], b[1]); w.w = cvt_pk_bf16(b[2], b[3]);
                            *(GAS u32x4*)(xb + off) = w;
                        } else { *(GAS f32x4*)(xout + off) = a; *(GAS f32x4*)(xout + off + 4) = b; }
                    }
                    if (!last) { ss += __shfl_xor(ss, 16); ss += __shfl_xor(ss, 32); if (fq == 0) __hip_atomic_fetch_add((GAS float*)(rsn + row), ss, __ATOMIC_RELAXED, __HIP_MEMORY_SCOPE_AGENT); }
                }
            return;
        }
        if (kind == K_MDOWN && u.pn == 4) {
            if (wc < 2) {
#pragma unroll
                for (int ai = 0; ai < 2; ++ai)
#pragma unroll
                    for (int m = 0; m < 4; ++m) {
                        const int row = row0 + ai * HALF + m * 16; const float sc = 1.0f / sqrtf(*(const GAS float*)(rs + row) * invn + EPS);
                        float* o = kpe + (size_t)row * 64 + lc;
                        *(GAS f32x4*)o = acc[ai][0][m][0] * sc; *(GAS f32x4*)(o + 4) = acc[ai][0][m][1] * sc;
                    }
            }
            return;
        }
        bf16_t* p0; bf16_t* p1; int ld0, ld1; float* ssd = nullptr; float* hs0 = nullptr; float* hs1 = nullptr; int hld = 0;
        if (kind == K_IN) { const int grp = u.pn >> 2, buf = grp % 3; bf16_t* base = d0 + (size_t)buf * (32u << 20);
            p0 = base + (grp / 3) * 1024 + (u.pn & 3) * 256 + lc; p1 = p0 + HALF; ld0 = ld1 = DM;
            if (grp == 4) { hs0 = kss + 2 * (u.pn & 3); hs1 = hs0 + 1; hld = 8; } }
        else if (kind == K_UKV) { p0 = d0 + u.pn * 128 + lc; ld0 = 2048; p1 = d1 + u.pn * 128 + lc; ld1 = 2048; hs0 = kss + u.pn; hld = 16; }
        else if (kind == K_MDOWN) { bf16_t* base = d0 + (size_t)(u.pn >> 1) * (8u << 20); p0 = base + (u.pn & 1) * 256 + lc; p1 = p0 + HALF; ld0 = ld1 = 512; ssd = rsq + (size_t)(u.pn >> 1) * M; }
        else { p0 = d0 + u.pn * BM + lc; p1 = p0 + HALF; ld0 = ld1 = ldc; }
        const bool act = (kind == K_UP);
#pragma unroll
        for (int ai = 0; ai < 2; ++ai)
#pragma unroll
            for (int m = 0; m < 4; ++m) {
                const int row = row0 + ai * HALF + m * 16; const float sc = 1.0f / sqrtf(*(const GAS float*)(rs + row) * invn + EPS); float ssb[2];
#pragma unroll
                for (int bj = 0; bj < 2; ++bj) {
                    f32x4 a = acc[ai][bj][m][0] * sc, b = acc[ai][bj][m][1] * sc;
                    if (act) {
#pragma unroll
                        for (int e = 0; e < 4; ++e) { const float x = fmaxf(a[e], 0.f), y = fmaxf(b[e], 0.f); a[e] = x * x; b[e] = y * y; }
                    }
                    ssb[bj] = (a[0] * a[0] + a[1] * a[1]) + (a[2] * a[2] + a[3] * a[3]) + (b[0] * b[0] + b[1] * b[1]) + (b[2] * b[2] + b[3] * b[3]);
                    u32x4 w; w.x = cvt_pk_bf16(a[0], a[1]); w.y = cvt_pk_bf16(a[2], a[3]); w.z = cvt_pk_bf16(b[0], b[1]); w.w = cvt_pk_bf16(b[2], b[3]);
                    bf16_t* dst = bj == 0 ? p0 + (size_t)row * ld0 : p1 + (size_t)row * ld1;
                    *(GAS u32x4*)dst = w;
                }
                if (hs0) { float t0 = ssb[0]; t0 += __shfl_xor(t0, 16); t0 += __shfl_xor(t0, 32); if (fq == 0) __hip_atomic_fetch_add((GAS float*)(hs0 + (size_t)row * hld), t0, __ATOMIC_RELAXED, __HIP_MEMORY_SCOPE_AGENT); }
                if (hs1) { float t1 = ssb[1]; t1 += __shfl_xor(t1, 16); t1 += __shfl_xor(t1, 32); if (fq == 0) __hip_atomic_fetch_add((GAS float*)(hs1 + (size_t)row * hld), t1, __ATOMIC_RELAXED, __HIP_MEMORY_SCOPE_AGENT); }
                const float ss = ssb[0] + ssb[1];
                if (ssd) { float t2 = ss; t2 += __shfl_xor(t2, 16); t2 += __shfl_xor(t2, 32); if (fq == 0) __hip_atomic_fetch_add((GAS float*)(ssd + row), t2, __ATOMIC_RELAXED, __HIP_MEMORY_SCOPE_AGENT); }
            }
    }
};

template <class EpiT, class Sched>
__device__ __forceinline__ void gemm_phase(LAS unsigned char* lds, const Gemm g, const Sched& S, const EpiT& E) {
    int tid_l = threadIdx.x; asm volatile("" : "+v"(tid_l));
    const int tid = tid_l, wid = __builtin_amdgcn_readfirstlane(tid >> 6), lane = tid & 63, wr = wid >> 2, wc = wid & 3, fr = lane & 15, fq = lane >> 4;
    const int K = g.K, nt = K / BK;
    unsigned voffA[2], voffB[2];
#pragma unroll
    for (int i = 0; i < 2; ++i) { int R, C; stage_rc(tid * 16 + i * 8192, R, C); const int Rb = EpiT::PERM ? ((R & ~31) + perm32(R & 31)) : R;
        voffA[i] = (unsigned)(R * K + C) * 2u; voffB[i] = (unsigned)(Rb * K + C) * 2u; }
    const size_t kstep = (size_t)(BK * 2);
    const size_t hstep = (size_t)HALF * K * 2;
    const size_t tstep = 2 * hstep;
    const unsigned ldsw = (unsigned)wid * 1024u;
    const int aoff = lds_byte(wr * 64 + fr, fq * 8), boff = lds_byte(wc * 32 + fr, fq * 8);
#define PG8_SA(b, h) (((b) * 2 + (h)) * HTB)
#define PG8_SB(b, h) ((4 + (b) * 2 + (h)) * HTB)
#define PG8_STAGE(bufoff, gbase, voff) do { _Pragma("unroll") for (int _i = 0; _i < 2; ++_i) \
        __builtin_amdgcn_global_load_lds((const unsigned*)((const char*)(gbase) + (voff)[_i]), (LAS unsigned*)(lds + (bufoff) + ldsw + _i * 8192), 16, 0, 0); } while (0)
#define PG8_LDA(dst, b, h) do { _Pragma("unroll") for (int m = 0; m < 4; ++m) _Pragma("unroll") for (int k = 0; k < 2; ++k) dst[m][k] = *(const LAS bf16x8*)(lds + PG8_SA(b, h) + aoff + m * 2048 + k * 1024); } while (0)
#define PG8_LDB(dst, b, h) do { _Pragma("unroll") for (int n = 0; n < 2; ++n) _Pragma("unroll") for (int k = 0; k < 2; ++k) dst[n][k] = *(const LAS bf16x8*)(lds + PG8_SB(b, h) + boff + n * 2048 + k * 1024); } while (0)
#define PG8_MMA(ai, bj, At, Bt) do { __builtin_amdgcn_s_setprio(1); _Pragma("unroll") for (int m = 0; m < 4; ++m) _Pragma("unroll") for (int n = 0; n < 2; ++n) _Pragma("unroll") for (int k = 0; k < 2; ++k) \
        acc[ai][bj][m][n] = __builtin_amdgcn_mfma_f32_16x16x32_bf16(Bt[n][k], At[m][k], acc[ai][bj][m][n], 0, 0, 0); __builtin_amdgcn_s_setprio(0); } while (0)
#define PG8_WAIT_V(n) asm volatile("s_waitcnt vmcnt(" #n ")" ::: "memory")
#define PG8_WAIT_L(n) asm volatile("s_waitcnt lgkmcnt(" #n ")" ::: "memory")
#define PG8_BAR __builtin_amdgcn_s_barrier()
#define PG8_SCHED __builtin_amdgcn_sched_barrier(0)
    Unit cur, nxt; int ui = 0;
    if (!S.next(0, cur)) return;
    f32x4 acc[2][2][4][2];
#pragma unroll
    for (int a = 0; a < 2; ++a)
#pragma unroll
        for (int b = 0; b < 2; ++b)
#pragma unroll
            for (int m = 0; m < 4; ++m)
#pragma unroll
                for (int n = 0; n < 2; ++n) acc[a][b][m][n] = (f32x4){0.f, 0.f, 0.f, 0.f};
    bf16x8 At[4][2], B0[2][2], B1[2][2];
    const char* cA = (const char*)g.A + (size_t)cur.pm * tstep; const char* cB = (const char*)g.Bt + (size_t)cur.pn * tstep;
    {
        PG8_STAGE(PG8_SB(0, 0), cB, voffB); PG8_STAGE(PG8_SB(0, 1), cB + hstep, voffB); PG8_STAGE(PG8_SA(0, 0), cA, voffA); PG8_STAGE(PG8_SA(0, 1), cA + hstep, voffA);
        if (wr == 1) PG8_BAR;
        PG8_WAIT_V(2); PG8_BAR;
        PG8_STAGE(PG8_SB(1, 0), cB + kstep, voffB); PG8_STAGE(PG8_SA(1, 0), cA + kstep, voffA); PG8_STAGE(PG8_SB(1, 1), cB + hstep + kstep, voffB);
        PG8_WAIT_V(6); PG8_BAR;
    }
    for (;;) {
        const bool has_next = S.next(ui + 1, nxt);
        const char* nA = has_next ? (const char*)g.A + (size_t)nxt.pm * tstep : cA; const char* nB = has_next ? (const char*)g.Bt + (size_t)nxt.pn * tstep : cB;
        for (int t = 0; t < nt; t += 2) {
            const bool last = (t == nt - 2);
            const char* a1 = cA + (size_t)(t + 1) * kstep;
            const char* a2 = last ? nA : cA + (size_t)(t + 2) * kstep; const char* b2 = last ? nB : cB + (size_t)(t + 2) * kstep;
            const char* a3 = a2 + kstep; const char* b3 = b2 + kstep;
            PG8_LDB(B0, 0, 0); PG8_LDB(B1, 0, 1); PG8_SCHED; PG8_LDA(At, 0, 0); PG8_STAGE(PG8_SA(1, 1), a1 + hstep, voffA);
            PG8_WAIT_V(8); PG8_WAIT_L(0); PG8_BAR; PG8_MMA(0, 0, At, B0); PG8_MMA(0, 1, At, B1); PG8_BAR; PG8_SCHED;
            PG8_LDA(At, 0, 1); PG8_STAGE(PG8_SB(0, 0), b2, voffB); PG8_STAGE(PG8_SB(0, 1), b2 + hstep, voffB); PG8_STAGE(PG8_SA(0, 0), a2, voffA);
            PG8_WAIT_V(8); PG8_WAIT_L(0); PG8_BAR; PG8_MMA(1, 0, At, B0); PG8_MMA(1, 1, At, B1); PG8_BAR; PG8_SCHED;
            PG8_LDB(B0, 1, 0); PG8_LDB(B1, 1, 1); PG8_SCHED; PG8_LDA(At, 1, 0); PG8_STAGE(PG8_SA(0, 1), a2 + hstep, voffA);
            PG8_WAIT_V(8); PG8_WAIT_L(0); PG8_BAR; PG8_MMA(0, 0, At, B0); PG8_MMA(0, 1, At, B1); PG8_BAR; PG8_SCHED;
            PG8_LDA(At, 1, 1); PG8_STAGE(PG8_SB(1, 0), b3, voffB); PG8_STAGE(PG8_SB(1, 1), b3 + hstep, voffB); PG8_STAGE(PG8_SA(1, 0), a3, voffA);
            PG8_WAIT_V(8); PG8_WAIT_L(0); PG8_BAR; PG8_MMA(1, 0, At, B0); PG8_MMA(1, 1, At, B1); PG8_BAR; PG8_SCHED;
        }
        if (wr == 0) PG8_BAR;
        E(acc, cur, wr, wc, fr, fq);
        if (!has_next) break;
#pragma unroll
        for (int a = 0; a < 2; ++a)
#pragma unroll
            for (int b = 0; b < 2; ++b)
#pragma unroll
                for (int m = 0; m < 4; ++m)
#pragma unroll
                    for (int n = 0; n < 2; ++n) acc[a][b][m][n] = (f32x4){0.f, 0.f, 0.f, 0.f};
        cur = nxt; cA = nA; cB = nB; ++ui;
        if (wr == 1) PG8_BAR;
    }
    PG8_WAIT_V(0);
    PG8_BAR;
#undef PG8_SA
#undef PG8_SB
#undef PG8_STAGE
#undef PG8_LDA
#undef PG8_LDB
#undef PG8_MMA
#undef PG8_WAIT_V
#undef PG8_WAIT_L
#undef PG8_BAR
#undef PG8_SCHED
}
}

#define KSWZ(row, colB) ((row) * 256 + ((colB) ^ (((row) & 15) << 4)))
#define PSWZ(row, colB) ((row) * 128 + ((colB) ^ ((((row) >> 1) & 7) << 4)))
#define SBAR() __builtin_amdgcn_sched_barrier(0)
#ifndef QK_DEP_MLA
#define QK_DEP_MLA 3
#endif
constexpr int A_V = 0, A_K = 49152, A_P = 81920, A_F = 98304, A_W = 99840, A_FLG = 101888, A_END = 101904, A_GL = 102400, A_RK = 105472, A_F2L = 121856;
__device__ __forceinline__ int v_st(int k, int c) { const int kk = (k & ~0xC) | ((k & 4) << 1) | ((k & 8) >> 1); return ((kk >> 3) * 4 + (c >> 5)) * 512 + ((kk & 7) * 32 + (c & 31)) * 2; }
__device__ __forceinline__ int v_rd_base(int lane) { return ((lane & 3) << 3) | (((lane >> 2) & 3) << 6) | (((lane >> 4) & 1) << 5) | (((lane >> 5) & 1) << 8); }
__device__ __forceinline__ int crow(int r, int hi) { return (r & 3) + 8 * (r >> 2) + 4 * hi; }
__device__ __forceinline__ float swap_sum(float v) { auto rr = __builtin_amdgcn_permlane32_swap(__float_as_uint(v), __float_as_uint(v), false, false); return __uint_as_float(rr[0]) + __uint_as_float(rr[1]); }
__device__ __forceinline__ float swap_max(float v) { auto rr = __builtin_amdgcn_permlane32_swap(__float_as_uint(v), __float_as_uint(v), false, false); return fmaxf(__uint_as_float(rr[0]), __uint_as_float(rr[1])); }

#define PK4(P, B_, OUT) do { unsigned a0 = cvt_pk_bf16(P[B_+0], P[B_+1]), a1 = cvt_pk_bf16(P[B_+2], P[B_+3]);                          \
        unsigned b0 = cvt_pk_bf16(P[B_+4], P[B_+5]), b1 = cvt_pk_bf16(P[B_+6], P[B_+7]);                                             \
        auto r0 = __builtin_amdgcn_permlane32_swap(a0, b0, false, false); auto r1 = __builtin_amdgcn_permlane32_swap(a1, b1, false, false); \
        u32x4 w = {r0[0], r1[0], r0[1], r1[1]}; OUT = __builtin_bit_cast(bf16x8, w); } while (0)

template <int MODE>
__device__ __forceinline__ void qkt(f32x16& p0, f32x16& p1, LAS const char* K_lds, LAS const char* P_lds, int kbuf, int r32, int hi, const bf16x8* qr) {
    constexpr int ND = (MODE == 2) ? 12 : 8, DEP = (MODE == 2) ? QK_DEP_MLA : 4;
    LAS const char* kbase = K_lds + kbuf * 16384;
    LAS const char* pbase = P_lds + kbuf * 8192;
    LAS const char* kb[4]; LAS const char* pb[4];
#pragma unroll
    for (int dd = 0; dd < 4; ++dd) { kb[dd] = kbase + KSWZ(r32, (dd * 16 + hi * 8) * 2); pb[dd] = pbase + PSWZ(r32, (dd * 16 + hi * 8) * 2); }
    bf16x8 kf[2 * DEP];
#define QK_LD(d, slot) do { if ((d) < 8) { LAS const char* a_ = ((d) < 4) ? kb[(d) & 3] : (LAS const char*)((unsigned)(size_t)kb[(d) & 3] ^ 128u); kf[2 * (slot)] = *(LAS const bf16x8*)a_; kf[2 * (slot) + 1] = *(LAS const bf16x8*)(a_ + 32 * 256); } \
                            else { LAS const char* a_ = pb[((d) - 8) & 3]; kf[2 * (slot)] = *(LAS const bf16x8*)a_; kf[2 * (slot) + 1] = *(LAS const bf16x8*)(a_ + 32 * 128); } } while (0)
#pragma unroll
    for (int d = 0; d < DEP; ++d) QK_LD(d, d);
    SBAR();
    const f32x16 zero = {0.f, 0.f, 0.f, 0.f, 0.f, 0.f, 0.f, 0.f, 0.f, 0.f, 0.f, 0.f, 0.f, 0.f, 0.f, 0.f};
#pragma unroll
    for (int d = 0; d < ND; ++d) {
        const int slot = d % DEP;
        if (d == 0) { p0 = __builtin_amdgcn_mfma_f32_32x32x16_bf16(kf[0], qr[0], zero, 0, 0, 0); p1 = __builtin_amdgcn_mfma_f32_32x32x16_bf16(kf[1], qr[0], zero, 0, 0, 0); }
        else { p0 = __builtin_amdgcn_mfma_f32_32x32x16_bf16(kf[2 * slot], qr[d], p0, 0, 0, 0); p1 = __builtin_amdgcn_mfma_f32_32x32x16_bf16(kf[2 * slot + 1], qr[d], p1, 0, 0, 0); }
        if (d + DEP < ND) QK_LD(d + DEP, slot);
        SBAR();
    }
#undef QK_LD
}
__device__ __forceinline__ void pv_tile(f32x16* o, int vb, bf16x8 pa0, bf16x8 pa1, bf16x8 pa2, bf16x8 pa3) {
#define TRRD(dst, off) asm volatile("ds_read_b64_tr_b16 %0, %1 offset:%2" : "=&v"(dst) : "v"(vb), "i"(off) : "memory")
#define PV_D0(d0) do { s16x4 l0, l1, l2, l3, h0, h1, h2, h3; constexpr int b_ = (d0) * 512; \
        TRRD(l0, b_); TRRD(h0, b_ + 2048); TRRD(l1, b_ + 4096); TRRD(h1, b_ + 6144); TRRD(l2, b_ + 8192); TRRD(h2, b_ + 10240); TRRD(l3, b_ + 12288); TRRD(h3, b_ + 14336); \
        asm volatile("s_waitcnt lgkmcnt(0)" ::: "memory"); SBAR();   \
        o[d0] = __builtin_amdgcn_mfma_f32_32x32x16_bf16(pa0, (bf16x8){l0[0], l0[1], l0[2], l0[3], h0[0], h0[1], h0[2], h0[3]}, o[d0], 0, 0, 0);   \
        o[d0] = __builtin_amdgcn_mfma_f32_32x32x16_bf16(pa1, (bf16x8){l1[0], l1[1], l1[2], l1[3], h1[0], h1[1], h1[2], h1[3]}, o[d0], 0, 0, 0);   \
        o[d0] = __builtin_amdgcn_mfma_f32_32x32x16_bf16(pa2, (bf16x8){l2[0], l2[1], l2[2], l2[3], h2[0], h2[1], h2[2], h2[3]}, o[d0], 0, 0, 0);   \
        o[d0] = __builtin_amdgcn_mfma_f32_32x32x16_bf16(pa3, (bf16x8){l3[0], l3[1], l3[2], l3[3], h3[0], h3[1], h3[2], h3[3]}, o[d0], 0, 0, 0); } while (0)
    PV_D0(0); PV_D0(1); PV_D0(2); PV_D0(3);
#undef PV_D0
#undef TRRD
}

template <int MODE>
__device__ __forceinline__ void attn_unit(LAS char* lds, const bf16_t* Qp, int ldq, const bf16_t* Kp, int ldk, const bf16_t* Vp, int ldv, bf16_t* Op, int ldo, const float* F2, int qb, float C2,
               const float* g1, const float* g2, const float* kss, int kss_ld, const float* sspe, const int* posb, const bf16_t* Kpe, bool fresh_tables) {
    constexpr int NQ = (MODE == 2) ? 12 : 8;
    int tid_l = threadIdx.x; asm volatile("" : "+v"(tid_l));
    const int tid = tid_l, wid = __builtin_amdgcn_readfirstlane(tid >> 6), lane = tid & 63, r32 = lane & 31, hi = lane >> 5;
    const bool grpB = wid >= 4;
    const int q0 = qb * 256, NT = 4 * qb + 4;
    const int qlo = q0 + wid * 32, tq = qlo + r32;
    LAS char* V_lds = lds + A_V; LAS char* K_lds = lds + A_K; LAS char* P_lds = lds + A_P; LAS float* F_lds = (LAS float*)(lds + A_F);
    LAS float* wsf = (LAS float*)(lds + A_W) + wid * 64; LAS float* li_l = wsf; LAS float* al_l = wsf + 32;
    LAS const float* GL = (LAS const float*)(lds + A_GL);
    const int sr = tid >> 4, sc = (tid & 15) * 8;
    const int vst0 = v_st(sr, sc), vst1 = v_st(32 + sr, sc), kws = KSWZ(sr, sc * 2);
    const int pr = tid >> 3, pc = (tid & 7) * 8, pws = PSWZ(pr, pc * 2);
    const int vb0 = (int)(size_t)V_lds + v_rd_base(lane);
    bf16x8 qr[NQ];
    {
        const bf16_t* qrow = Qp + (size_t)tq * ldq + hi * 8;
#pragma unroll
        for (int d0 = 0; d0 < NQ; ++d0) qr[d0] = *(const GAS bf16x8*)(qrow + d0 * 16);
    }
    float f2t = 0.f; if constexpr (MODE == 1) f2t = *(const GAS float*)(F2 + tq);
    bf16x8 st_k0, st_k1, st_v0, st_v1, st_kp;
#define JT(t) ((MODE == 0) ? (NT - 1 - (t)) : (t))
#define SLOAD(j) do { const int k0_ = (j) * 64; \
        st_k0 = *(const GAS bf16x8*)(Kp + (size_t)(k0_ + sr) * ldk + sc); st_k1 = *(const GAS bf16x8*)(Kp + (size_t)(k0_ + 32 + sr) * ldk + sc); \
        st_v0 = *(const GAS bf16x8*)(Vp + (size_t)(k0_ + sr) * ldv + sc); st_v1 = *(const GAS bf16x8*)(Vp + (size_t)(k0_ + 32 + sr) * ldv + sc); \
        if constexpr (MODE == 2) { st_kp = *(const GAS bf16x8*)(Kpe + (size_t)(k0_ + pr) * 64 + pc); } } while (0)
#define SWRITE(kbf, vbf) do { *(LAS bf16x8*)(K_lds + (kbf) * 16384 + kws) = st_k0; *(LAS bf16x8*)(K_lds + (kbf) * 16384 + kws + 32 * 256) = st_k1; \
        *(LAS bf16x8*)(V_lds + (vbf) * 16384 + vst0) = st_v0; *(LAS bf16x8*)(V_lds + (vbf) * 16384 + vst1) = st_v1; \
        if constexpr (MODE == 2) *(LAS bf16x8*)(P_lds + (kbf) * 8192 + pws) = st_kp; \
        } while (0)
    float m_reg = -1e30f, l_reg = 0.f, Rc = 0.f; bool wdone = false, stop = false, pend = false;
    int pj = 0, pv3 = 0;
    LAS int* flg = (LAS int*)(lds + A_FLG);
    if constexpr (MODE == 0) { if (tid < 4) flg[tid] = 0; }
    const float m0 = hi == 0 ? 1.f : 0.f;

    SLOAD(JT(0));
    LAS float* RK = (LAS float*)(lds + A_RK); LAS float* F2L = (LAS float*)(lds + A_F2L);
    if constexpr (MODE != 0) {
        if (fresh_tables) {
            const int nk = q0 + 256;
            float rv[8], sv[8], fv[8];
#pragma unroll
            for (int i = 0; i < 8; ++i) { const int k = tid + 512 * i; rv[i] = 1.f; sv[i] = 0.f; fv[i] = 0.f;
                if (k < nk) { rv[i] = *(const GAS float*)(kss + (size_t)k * kss_ld);
                    if constexpr (MODE == 2) sv[i] = *(const GAS float*)(sspe + k);
                    if constexpr (MODE == 1) fv[i] = *(const GAS float*)(F2 + k); } }
#pragma unroll
            for (int i = 0; i < 8; ++i) { const int k = tid + 512 * i;
                if (k < nk) { RK[k] = C2 / sqrtf((rv[i] + sv[i]) * ((MODE == 1) ? (1.0f / 128.f) : (1.0f / 192.f)) + EPS);
                    if constexpr (MODE == 1) F2L[k] = fv[i]; } }
        }
    }
    if constexpr (MODE == 1) {
        float ss = 0.f;
#pragma unroll
        for (int d0 = 0; d0 < 8; ++d0)
#pragma unroll
            for (int e = 0; e < 8; ++e) { const float f = bf2f(qr[d0][e]); ss += f * f; }
        ss = swap_sum(ss);
        const float rstd = 1.0f / sqrtf(ss * (1.0f / 128.f) + EPS);
#pragma unroll
        for (int d0 = 0; d0 < 8; ++d0) { const int d = d0 * 16 + hi * 8;
            const f32x4 ga = *(LAS const f32x4*)(GL + d), gb = *(LAS const f32x4*)(GL + d + 4);
            float f[8];
#pragma unroll
            for (int e = 0; e < 4; ++e) { f[e] = bf2f(qr[d0][e]) * rstd * ga[e]; f[4 + e] = bf2f(qr[d0][4 + e]) * rstd * gb[e]; }
            u32x4 w; w.x = cvt_pk_bf16(f[0], f[1]); w.y = cvt_pk_bf16(f[2], f[3]); w.z = cvt_pk_bf16(f[4], f[5]); w.w = cvt_pk_bf16(f[6], f[7]);
            qr[d0] = __builtin_bit_cast(bf16x8, w); }
    }
    if constexpr (MODE == 2) {
        float ss = 0.f;
#pragma unroll
        for (int d0 = 0; d0 < 12; ++d0)
#pragma unroll
            for (int e = 0; e < 8; ++e) { const float f = bf2f(qr[d0][e]); ss += f * f; }
        ss = swap_sum(ss);
        const float rstd = 1.0f / sqrtf(ss * (1.0f / 192.f) + EPS);
#pragma unroll
        for (int d0 = 0; d0 < 8; ++d0) { const int d = d0 * 16 + hi * 8;
            const f32x4 ga = *(LAS const f32x4*)(GL + d), gb = *(LAS const f32x4*)(GL + d + 4);
            float f[8];
#pragma unroll
            for (int e = 0; e < 4; ++e) { f[e] = bf2f(qr[d0][e]) * rstd * ga[e]; f[4 + e] = bf2f(qr[d0][4 + e]) * rstd * gb[e]; }
            u32x4 w; w.x = cvt_pk_bf16(f[0], f[1]); w.y = cvt_pk_bf16(f[2], f[3]); w.z = cvt_pk_bf16(f[4], f[5]); w.w = cvt_pk_bf16(f[6], f[7]);
            qr[d0] = __builtin_bit_cast(bf16x8, w); }
        const float posf = (float)*(const GAS int*)(posb + tq);
#pragma unroll
        for (int f = 0; f < 2; ++f) { const int d1 = 128 + 16 * f + hi * 8, d2 = d1 + 32;
            const f32x4 ga = *(LAS const f32x4*)(GL + d1), gb = *(LAS const f32x4*)(GL + d1 + 4), ha = *(LAS const f32x4*)(GL + d2), hb = *(LAS const f32x4*)(GL + d2 + 4);
            const f32x4 iva = *(LAS const f32x4*)(GL + 512 + 16 * f + 8 * hi), ivb = *(LAS const f32x4*)(GL + 512 + 16 * f + 8 * hi + 4);
            float o1[8], o2[8];
#pragma unroll
            for (int e = 0; e < 8; ++e) {
                const float t1 = bf2f(qr[8 + f][e]) * rstd * (e < 4 ? ga[e & 3] : gb[e & 3]);
                const float t2 = bf2f(qr[10 + f][e]) * rstd * (e < 4 ? ha[e & 3] : hb[e & 3]);
                const float inv = (e < 4 ? iva[e & 3] : ivb[e & 3]);
                const float ang = posf * inv;
                const float kq = rintf(ang * 0.15915494309189535f);
                float rr = fmaf(-kq, 6.28125f, ang); rr = fmaf(-kq, 1.9353071795864769e-3f, rr);
                const float sn = __sinf(rr), cs = __cosf(rr);
                o1[e] = t1 * cs - t2 * sn; o2[e] = t2 * cs + t1 * sn;
            }
            u32x4 w1, w2;
            w1.x = cvt_pk_bf16(o1[0], o1[1]); w1.y = cvt_pk_bf16(o1[2], o1[3]); w1.z = cvt_pk_bf16(o1[4], o1[5]); w1.w = cvt_pk_bf16(o1[6], o1[7]);
            w2.x = cvt_pk_bf16(o2[0], o2[1]); w2.y = cvt_pk_bf16(o2[2], o2[3]); w2.z = cvt_pk_bf16(o2[4], o2[5]); w2.w = cvt_pk_bf16(o2[6], o2[7]);
            qr[8 + f] = __builtin_bit_cast(bf16x8, w1); qr[10 + f] = __builtin_bit_cast(bf16x8, w2); }
    }
    f32x16 o[4]; f32x16 p0, p1;
#pragma unroll
    for (int d = 0; d < 4; ++d)
#pragma unroll
        for (int r = 0; r < 16; ++r) o[d][r] = 0.f;
#pragma unroll
    for (int r = 0; r < 16; ++r) { p0[r] = 0.f; p1[r] = 0.f; }
    SWRITE(0, 0); __syncthreads();

#define SBHALF(P, coff, carry_in, run_out) do { f32x16 lq; \
        _Pragma("unroll") for (int r = 0; r < 16; ++r) { const float z = P[r] * C2; const float e = __builtin_amdgcn_exp2f(-fabsf(z)); const float L = __builtin_amdgcn_logf(1.f + e); const float lb = fminf(z, 0.f) - L; P[r] = lb; lq[r] = lb - z; } \
        if (needmask) { const float NEG = -__builtin_inff(); \
            _Pragma("unroll") for (int r = 0; r < 16; ++r) { const int c = (r & 3) + 8 * (r >> 2) + (coff); if (dq - c <= 0) { P[r] = NEG; lq[r] = 0.f; } } } \
        float mn_[4], pr_[4], th_[4], bs_[4]; \
        _Pragma("unroll") for (int i = 0; i < 4; ++i) mn_[i] = (lq[4*i] + lq[4*i+1]) + (lq[4*i+2] + lq[4*i+3]); \
        _Pragma("unroll") for (int i = 0; i < 4; ++i) { auto rr = __builtin_amdgcn_permlane32_swap(__float_as_uint(mn_[i]), __float_as_uint(mn_[i]), false, false); \
            pr_[i] = __uint_as_float(rr[0]) + __uint_as_float(rr[1]); th_[i] = __uint_as_float(rr[1]) * m0; } \
        float run = (carry_in); \
        _Pragma("unroll") for (int i = 3; i >= 0; --i) { bs_[i] = run + th_[i]; run += pr_[i]; } \
        _Pragma("unroll") for (int i = 0; i < 4; ++i) { float s = bs_[i]; \
            const float w3 = __builtin_amdgcn_exp2f(P[4*i+3] + s); s += lq[4*i+3]; const float w2 = __builtin_amdgcn_exp2f(P[4*i+2] + s); s += lq[4*i+2]; \
            const float w1 = __builtin_amdgcn_exp2f(P[4*i+1] + s); s += lq[4*i+1]; const float w0 = __builtin_amdgcn_exp2f(P[4*i] + s); \
            P[4*i] = w0; P[4*i+1] = w1; P[4*i+2] = w2; P[4*i+3] = w3; } \
        run_out = run; } while (0)

#define SMPV(j_, v3_) do { const int kb_ = (j_) * 64; bf16x8 pa0, pa1, pa2, pa3; \
        const bool needmask = kb_ + 63 >= qlo; const int dq = tq - kb_ - 4 * hi; \
        if constexpr (MODE == 0) { \
            float r1_, r0_; \
            SBHALF(p1, 32, Rc, r1_); SBHALF(p0, 0, r1_, r0_); \
            Rc = r0_; wdone = __all(Rc < -160.f); \
        } else { \
            if constexpr (MODE == 1) { \
                _Pragma("unroll") for (int i = 0; i < 4; ++i) { const f32x4 fa = *(LAS const f32x4*)(F2L + kb_ + 8 * i + 4 * hi); const f32x4 fb = *(LAS const f32x4*)(F2L + kb_ + 32 + 8 * i + 4 * hi); \
                    const f32x4 ra = *(LAS const f32x4*)(RK + kb_ + 8 * i + 4 * hi); const f32x4 rb = *(LAS const f32x4*)(RK + kb_ + 32 + 8 * i + 4 * hi); \
                    _Pragma("unroll") for (int u = 0; u < 4; ++u) { p0[4*i+u] = fmaf(p0[4*i+u], ra[u], f2t - fa[u]); p1[4*i+u] = fmaf(p1[4*i+u], rb[u], f2t - fb[u]); } } \
            } else { \
                _Pragma("unroll") for (int i = 0; i < 4; ++i) { const f32x4 ra = *(LAS const f32x4*)(RK + kb_ + 8 * i + 4 * hi); const f32x4 rb = *(LAS const f32x4*)(RK + kb_ + 32 + 8 * i + 4 * hi); \
                    _Pragma("unroll") for (int u = 0; u < 4; ++u) { p0[4*i+u] *= ra[u]; p1[4*i+u] *= rb[u]; } } \
            } \
            if (needmask) { const float NEG = -__builtin_inff(); \
                _Pragma("unroll") for (int r = 0; r < 16; ++r) { const int c = (r & 3) + 8 * (r >> 2); if (dq - c < 0) p0[r] = NEG; if (dq - c - 32 < 0) p1[r] = NEG; } } \
            float pma = fmaxf(fmaxf(p0[0], p0[1]), p1[0]), pmb = fmaxf(fmaxf(p0[2], p0[3]), p1[1]); pma = fmaxf(fmaxf(pma, p1[2]), p1[3]); \
            _Pragma("unroll") for (int r = 4; r < 16; r += 4) { pma = fmaxf(fmaxf(pma, p0[r]), p0[r+1]); pmb = fmaxf(fmaxf(pmb, p0[r+2]), p0[r+3]); pma = fmaxf(fmaxf(pma, p1[r]), p1[r+1]); pmb = fmaxf(fmaxf(pmb, p1[r+2]), p1[r+3]); } \
            float pmax = swap_max(fmaxf(pma, pmb)); \
            const float SC = 1.f; \
            float mn, alpha; \
            if (__all(pmax - m_reg <= 11.5f)) { mn = m_reg; alpha = 1.f; } else { mn = fmaxf(m_reg, pmax); alpha = __builtin_amdgcn_exp2f(m_reg - mn); m_reg = mn; } \
            float psa = 0.f, psb = 0.f; const float nmn = -mn; \
            _Pragma("unroll") for (int r = 0; r < 16; ++r) { p0[r] = __builtin_amdgcn_exp2f(fmaf(p0[r], SC, nmn)); p1[r] = __builtin_amdgcn_exp2f(fmaf(p1[r], SC, nmn)); psa += p0[r]; psb += p1[r]; } \
            const float ps = swap_sum(psa + psb); l_reg = l_reg * alpha + ps; \
            if (__any(alpha < 1.f)) { if (hi == 0) al_l[r32] = alpha; asm volatile("s_waitcnt lgkmcnt(0)" ::: "memory"); \
                _Pragma("unroll") for (int r = 0; r < 16; ++r) { const float a_ = al_l[crow(r, hi)]; o[0][r] *= a_; o[1][r] *= a_; o[2][r] *= a_; o[3][r] *= a_; } \
                asm volatile("s_waitcnt lgkmcnt(0)" ::: "memory"); } \
        } \
        PK4(p0, 0, pa0); PK4(p0, 8, pa1); PK4(p1, 0, pa2); PK4(p1, 8, pa3); \
        SBAR(); pv_tile(o, vb0 + (v3_) * 16384, pa0, pa1, pa2, pa3); } while (0)

    int k2 = 0, v3 = 0;
    if (grpB) __builtin_amdgcn_s_setprio(1);
#pragma nounroll
    for (int t = 0; t <= NT; ++t) {
        const bool more = t < NT;
        const int j = JT(t), kb = j * 64;
        if (t + 1 < NT) SLOAD(JT(t + 1));
        const bool inrange = more && (kb <= qlo + 31);
        if (!grpB && inrange && !wdone) { qkt<MODE>(p0, p1, K_lds, P_lds, k2, r32, hi, qr); pend = true; pj = j; pv3 = v3; }
        if (pend) { SMPV(pj, pv3); pend = false; }
        if (grpB && inrange && !wdone) { qkt<MODE>(p0, p1, K_lds, P_lds, k2, r32, hi, qr); pend = true; pj = j; pv3 = v3; }
        const int k2n = k2 ^ 1, v3n = (v3 == 2) ? 0 : v3 + 1;
        if constexpr (MODE == 0) { if ((!wdone || pend) && lane == 0) flg[v3] = 1; }
        if (t + 1 < NT) { SWRITE(k2n, v3n); }
        __syncthreads();
        if constexpr (MODE == 0) { const int any_ = flg[v3]; if (tid == 0) flg[(v3n == 2) ? 0 : v3n + 1] = 0; if (!any_) stop = true; }
        k2 = k2n; v3 = v3n;
        if (stop) break;
    }

    __builtin_amdgcn_s_setprio(0);
    float rli[16];
    if constexpr (MODE == 0) {
#pragma unroll
        for (int r = 0; r < 16; ++r) rli[r] = 1.f;
    } else {
        if (hi == 0) li_l[r32] = l_reg; asm volatile("s_waitcnt lgkmcnt(0)" ::: "memory");
#pragma unroll
        for (int r = 0; r < 16; ++r) rli[r] = 1.0f / li_l[crow(r, hi)];
        asm volatile("s_waitcnt lgkmcnt(0)" ::: "memory");
    }
    bf16_t* Ow = Op + (size_t)qlo * ldo;
    LAS bf16_t* stg = (LAS bf16_t*)(lds + wid * 8192);
#pragma unroll
    for (int r = 0; r < 16; ++r) { const int orow = crow(r, hi);
#pragma unroll
        for (int d0 = 0; d0 < 4; ++d0) { const float v = o[d0][r] * rli[r]; stg[orow * 128 + d0 * 32 + r32] = (bf16_t)(cvt_pk_bf16(v, v) & 0xffffu); } }
    asm volatile("s_waitcnt lgkmcnt(0)" ::: "memory");
#pragma unroll
    for (int i = 0; i < 8; ++i) { const int row = i * 4 + (lane >> 4), ch = lane & 15;
        const u32x4 v = *(LAS const u32x4*)(stg + row * 128 + ch * 8);
        *(GAS u32x4*)(Ow + (size_t)row * ldo + ch * 8) = v; }
    __syncthreads();
#undef JT
#undef SLOAD
#undef SWRITE
#undef SMPV
#undef SBHALF
}


#define XB_TMO      128
#define XB_XCNT(j)  (256  + 64 * (j))
#define XB_XSUB(j)  (1280 + 64 * (j))
#define XB_XGEN(j)  (2304 + 64 * (j))
#define XB_TOP      3328
#define XB_TOPGEN   3392
#define XCD_BAR_WORDS 3456
#define XB_SPIN_CAP (1u << 18)

__device__ __forceinline__ unsigned xb_ld(unsigned* p)              { return __hip_atomic_load(p, __ATOMIC_RELAXED, __HIP_MEMORY_SCOPE_AGENT); }
__device__ __forceinline__ unsigned xb_add(unsigned* p, unsigned v) { return __hip_atomic_fetch_add(p, v, __ATOMIC_RELAXED, __HIP_MEMORY_SCOPE_AGENT); }
__device__ __forceinline__ unsigned xb_xcc_id() { return (unsigned)__builtin_amdgcn_s_getreg((3 << 11) | 20) & 0xFu; }
#define XB_SPIN(cond, bar) do { unsigned _sp = 0; while (cond) { __builtin_amdgcn_s_sleep(1); \
    if ((++_sp & 255u) == 0u) { if (xb_ld(&(bar)[XB_TMO])) break; if (_sp > XB_SPIN_CAP) { atomicAdd(&(bar)[XB_TMO], 1u); break; } } } } while (0)

struct XcdBarrier {
    unsigned* bar; unsigned x;
    volatile LAS unsigned* st;
};

__device__ __forceinline__ XcdBarrier xcd_barrier_post(unsigned* bar, volatile LAS unsigned* st) {
    XcdBarrier b; b.bar = bar; b.x = xb_xcc_id(); b.st = st;
    if (threadIdx.x == 0) (void)xb_add(&bar[XB_XCNT(b.x)], 1u);
    return b;
}
__device__ __forceinline__ void xcd_barrier_complete(unsigned* bar, unsigned x, unsigned& nloc, unsigned& nx) {
    const unsigned G = gridDim.x * gridDim.y * gridDim.z;
    unsigned sum, cnt, mine, sp = 0u;
    for (;;) {
        sum = 0u; cnt = 0u; mine = 0u;
#pragma unroll
        for (unsigned j = 0; j < 16; ++j) { const unsigned c = xb_ld(&bar[XB_XCNT(j)]); sum += c; cnt += (c > 0u) ? 1u : 0u; mine = (j == x) ? c : mine; }
        if (sum == G) break;
        __builtin_amdgcn_s_sleep(1);
        if ((++sp & 255u) == 0u) { if (xb_ld(&bar[XB_TMO])) break; if (sp > XB_SPIN_CAP) { atomicAdd(&bar[XB_TMO], 1u); break; } }
    }
    nloc = mine > 0u ? mine : 1u; nx = cnt > 0u ? cnt : 1u;
}

__device__ __forceinline__ void xcd_barrier(const XcdBarrier& b) {
    asm volatile("s_waitcnt vmcnt(0)" ::: "memory");
    __syncthreads();
    if (threadIdx.x == 0) {
        unsigned* bar = b.bar;
        __builtin_amdgcn_s_waitcnt(0);
        unsigned nloc = b.st[0], nx = b.st[1];
        if (nloc == 0u) { xcd_barrier_complete(bar, b.x, nloc, nx); b.st[0] = nloc; b.st[1] = nx; }
        const unsigned old = xb_add(&bar[XB_XSUB(b.x)], 1u);
        const unsigned gen = old / nloc;
        if (old + 1u == (gen + 1u) * nloc) {
            __builtin_amdgcn_fence(__ATOMIC_RELEASE, "agent");
            asm volatile("s_waitcnt vmcnt(0)" ::: "memory");
            const unsigned og = xb_add(&bar[XB_TOP], 1u);
            const unsigned tg = og / nx;
            if (og + 1u == (tg + 1u) * nx) xb_add(&bar[XB_TOPGEN], 1u);
            else XB_SPIN(xb_ld(&bar[XB_TOPGEN]) == tg, bar);
            __builtin_amdgcn_fence(__ATOMIC_ACQUIRE, "agent");
            xb_add(&bar[XB_XGEN(b.x)], 1u);
            asm volatile("s_waitcnt vmcnt(0)" ::: "memory");
        } else {
            XB_SPIN(xb_ld(&bar[XB_XGEN(b.x)]) == gen, bar);
            __builtin_amdgcn_fence(__ATOMIC_ACQUIRE, "agent");
            asm volatile("s_waitcnt vmcnt(0)" ::: "memory");
        }
    }
    __syncthreads();
}

struct Params {
    const float* x; const int* pos; const float* ln_mix_g; const float* ln_mlp_g; const float* w_in; const float* b_f; const float* fox_q_g; const float* fox_k_g; const float* w_o0;
    const float* mla_w_down; const float* q_a_g; const float* kv_a_g; const float* w_uq; const float* w_ukv; const float* mla_q_g; const float* mla_k_g; const float* w_o1;
    const float* w_up; const float* w_dn; float* out; unsigned char* ws;
};

__device__ __forceinline__ void transpose_block_item(const float* W, int K, int N, int ldw, const float* g, bf16_t* WT, LAS float* tile, int item, int tid) {
    const int nblk = (N + 255) / 256, kb = item / nblk, nb = item % nblk, k0 = 64 * kb, n0 = 256 * nb;
    const int rr = tid >> 6, c4 = (tid & 63) * 4;
    const bool colok = n0 + c4 < N;
    f32x4 tv[8];
#pragma unroll
    for (int i = 0; i < 8; ++i) tv[i] = colok ? *(const GAS f32x4*)(W + (size_t)(k0 + i * 8 + rr) * ldw + n0 + c4) : (f32x4){0.f, 0.f, 0.f, 0.f};
    if (g) {
#pragma unroll
        for (int i = 0; i < 8; ++i) tv[i] = tv[i] * *(const GAS float*)(g + k0 + i * 8 + rr);
    }
#pragma unroll
    for (int i = 0; i < 8; ++i) *(LAS f32x4*)(tile + (i * 8 + rr) * 260 + c4) = tv[i];
    __syncthreads();
    const int n = tid >> 1, kh = (tid & 1) * 32;
    if (n0 + n < N) {
        float f[32];
#pragma unroll
        for (int j = 0; j < 32; ++j) f[j] = tile[(kh + j) * 260 + n];
        bf16_t* dst = WT + (size_t)(n0 + n) * K + k0 + kh;
#pragma unroll
        for (int q = 0; q < 4; ++q) { u32x4 o; o.x = cvt_pk_bf16(f[8 * q], f[8 * q + 1]); o.y = cvt_pk_bf16(f[8 * q + 2], f[8 * q + 3]); o.z = cvt_pk_bf16(f[8 * q + 4], f[8 * q + 5]); o.w = cvt_pk_bf16(f[8 * q + 6], f[8 * q + 7]);
            *(GAS u32x4*)(dst + 8 * q) = o; }
    }
    __syncthreads();
}

__device__ __forceinline__ void transpose_item(const float* W, int K, int N, int ldw, const float* g, bf16_t* WT, LAS float* scr, int item, int lane) {
    const int nblk = N / 32, kb = item / nblk, nb = item % nblk, k0 = 64 * kb, n0 = 32 * nb;
    float tv[32];
    const float* wp = W + (size_t)(k0 + (lane >> 5)) * ldw + n0 + (lane & 31);
#pragma unroll
    for (int i = 0; i < 32; ++i) tv[i] = wp[(size_t)(2 * i) * ldw];
    if (g) {
#pragma unroll
        for (int i = 0; i < 32; ++i) tv[i] *= g[k0 + 2 * i + (lane >> 5)];
    }
#pragma unroll
    for (int i = 0; i < 32; ++i) scr[(2 * i + (lane >> 5)) * 33 + (lane & 31)] = tv[i];
    asm volatile("s_waitcnt lgkmcnt(0)" ::: "memory");
    const int c = lane & 7;
#pragma unroll
    for (int j = 0; j < 4; ++j) { const int n = (lane >> 3) + 8 * j; const LAS float* s = scr + (8 * c) * 33 + n;
        u32x4 o; o.x = cvt_pk_bf16(s[0 * 33], s[1 * 33]); o.y = cvt_pk_bf16(s[2 * 33], s[3 * 33]); o.z = cvt_pk_bf16(s[4 * 33], s[5 * 33]); o.w = cvt_pk_bf16(s[6 * 33], s[7 * 33]);
        *(u32x4*)(WT + (size_t)(n0 + n) * K + k0 + 8 * c) = o; }
    asm volatile("s_waitcnt lgkmcnt(0)" ::: "memory");
}

__global__ void __launch_bounds__(512) mega_fwd(Params p) {
    extern __shared__ __attribute__((aligned(16))) unsigned char lds_raw[];
    LAS unsigned char* lds = (LAS unsigned char*)lds_raw;
    cg::grid_group grid = cg::this_grid();
    const int G = gridDim.x, bx = blockIdx.x; const int vcu = (G % 8 == 0) ? (bx % 8) * (G / 8) + bx / 8 : bx;
    const int NGW = G * 8;
    volatile LAS unsigned* bst = (volatile LAS unsigned*)(lds + LDS_BYTES - 16);
    if (threadIdx.x < 4) bst[threadIdx.x] = 0u;
    __syncthreads();
    const XcdBarrier xbar = xcd_barrier_post((unsigned*)(p.ws + WS_BAR), bst);
    if (p.ws == nullptr) grid.sync();
#pragma nounroll
    for (int step = 0; step < 15; ++step) {
        if (step == 2 || step == 10) continue;
        for (int rep = 0; rep < 1 + ((DUP_MASK >> step) & 1); ++rep) {
        int tid_l = threadIdx.x; asm volatile("" : "+v"(tid_l));
        const int tid = tid_l, lane = tid & 63, wave = __builtin_amdgcn_readfirstlane(tid >> 6);
        const int gw = vcu * 8 + wave;
        unsigned char* ws = p.ws; asm volatile("" : "+s"(ws));
        float* RS = (float*)(ws + WS_RS); float* RS0 = RS, *RS1 = RS + M, *RS2 = RS + 2 * M, *RS3 = RS + 3 * M, *RSQ = RS + 4 * M, *RSKV = RS + 5 * M;
        float* LF = (float*)(ws + WS_LF); float* F2 = (float*)(ws + WS_F2); float* KPE = (float*)(ws + WS_KPE);
        bf16_t* XB = (bf16_t*)(ws + WS_XB);
        bf16_t* Q0 = (bf16_t*)(ws + WS_Q0); bf16_t* K0 = (bf16_t*)(ws + WS_K0); bf16_t* V0 = (bf16_t*)(ws + WS_V0); bf16_t* HB = (bf16_t*)(ws + WS_H);
        bf16_t* Q1 = (bf16_t*)(ws + WS_Q1); bf16_t* K1 = (bf16_t*)(ws + WS_K1); bf16_t* V1 = (bf16_t*)(ws + WS_V1);
        float* KSS0 = (float*)(ws + WS_KSS0); float* KSS1 = (float*)(ws + WS_KSS1); bf16_t* KPR = (bf16_t*)(ws + WS_KPR); float* SSPE = (float*)(ws + WS_SSPE);
        bf16_t* AO0 = (bf16_t*)(ws + WS_AO0); bf16_t* CQ = (bf16_t*)(ws + WS_CQ); bf16_t* CKV = (bf16_t*)(ws + WS_CKV); bf16_t* AO1 = (bf16_t*)(ws + WS_AO1);
        if (step == 0) {
            LAS float* scr = (LAS float*)(lds + wave * 8448);
            LAS float* wfg = (LAS float*)(lds + 67584);
            for (int idx = tid; idx < 16384; idx += 512) { const int k = idx >> 3, j = idx & 7; wfg[j * 2048 + k] = p.w_in[(size_t)k * INW + 6144 + j] * p.ln_mix_g[k]; }
            for (int i = bx * 512 + tid; i < 5 * M; i += G * 512) RS1[i] = 0.f;
            for (int i = bx * 512 + tid; i < 8 * M; i += G * 512) KSS0[i] = 0.f;
            for (int i = bx * 512 + tid; i < 16 * M; i += G * 512) KSS1[i] = 0.f;
            __syncthreads();
            constexpr int I_IN = 32 * 24, I_O = 32 * 8, I_UP = 32 * 32, I_DN = 128 * 8, I_MD = 32 * 5, I_UQ = 8 * 12, I_UKV = 8 * 16;
            constexpr int NITEMS = I_IN + 2 * I_O + 2 * I_UP + 2 * I_DN + I_MD + I_UQ + I_UKV;
            LAS float* tile = (LAS float*)lds;
            for (int it = vcu; it < NITEMS; it += G) {
                int r = it;
                if (r < I_IN) { transpose_block_item(p.w_in, 2048, 6144, INW, p.ln_mix_g, (bf16_t*)(ws + WS_WIN), tile, r, tid); continue; } r -= I_IN;
                if (r < I_O) { transpose_block_item(p.w_o0, 2048, 2048, 2048, nullptr, (bf16_t*)(ws + WS_WO0), tile, r, tid); continue; } r -= I_O;
                if (r < I_UP) { transpose_block_item(p.w_up, 2048, 8192, 8192, p.ln_mlp_g, (bf16_t*)(ws + WS_WUP0), tile, r, tid); continue; } r -= I_UP;
                if (r < I_DN) { transpose_block_item(p.w_dn, 8192, 2048, 2048, nullptr, (bf16_t*)(ws + WS_WDN0), tile, r, tid); continue; } r -= I_DN;
                if (r < I_MD) { transpose_block_item(p.mla_w_down, 2048, 1088, 1088, p.ln_mix_g + 2048, (bf16_t*)(ws + WS_WMD), tile, r, tid); continue; } r -= I_MD;
                if (r < I_UQ) { transpose_block_item(p.w_uq, 512, 3072, 3072, p.q_a_g, (bf16_t*)(ws + WS_WUQ), tile, r, tid); continue; } r -= I_UQ;
                if (r < I_UKV) { transpose_block_item(p.w_ukv, 512, 4096, 4096, p.kv_a_g, (bf16_t*)(ws + WS_WUKV), tile, r, tid); continue; } r -= I_UKV;
                if (r < I_O) { transpose_block_item(p.w_o1, 2048, 2048, 2048, nullptr, (bf16_t*)(ws + WS_WO1), tile, r, tid); continue; } r -= I_O;
                if (r < I_UP) { transpose_block_item(p.w_up + (size_t)2048 * 8192, 2048, 8192, 8192, p.ln_mlp_g + 2048, (bf16_t*)(ws + WS_WUP1), tile, r, tid); continue; } r -= I_UP;
                transpose_block_item(p.w_dn + (size_t)8192 * 2048, 8192, 2048, 2048, nullptr, (bf16_t*)(ws + WS_WDN1), tile, r, tid);
            }
            __syncthreads();
            for (int m = gw; m < M; m += NGW) {
                const f32x4* xr = (const f32x4*)(p.x + (size_t)m * DM) + lane;
                f32x4 v[8]; float ss = 0.f;
#pragma unroll
                for (int c = 0; c < 8; ++c) { v[c] = xr[64 * c]; ss += (v[c][0] * v[c][0] + v[c][1] * v[c][1]) + (v[c][2] * v[c][2] + v[c][3] * v[c][3]); }
                float d[8];
#pragma unroll
                for (int j = 0; j < 8; ++j) { float a = 0.f;
#pragma unroll
                    for (int c = 0; c < 8; ++c) { const f32x4 w = *(LAS const f32x4*)(wfg + j * 2048 + c * 256 + lane * 4); a += (v[c][0] * w[0] + v[c][1] * w[1]) + (v[c][2] * w[2] + v[c][3] * w[3]); }
                    d[j] = wave_sum(a); }
                ss = wave_sum(ss);
                const float rstd = 1.0f / sqrtf(ss * (1.0f / DM) + EPS);
                if (lane == 0) RS0[m] = ss;
                if (lane < 8) { float dj = d[0];
#pragma unroll
                    for (int j = 1; j < 8; ++j) dj = (lane == j) ? d[j] : dj;
                    const float lg = dj * rstd + p.b_f[lane]; const float ls = fminf(lg, 0.f) - log1pf(expf(-fabsf(lg)));
                    LF[((size_t)(m / SEQ) * 8 + lane) * SEQ + (m % SEQ)] = ls * LOG2E; }
#pragma unroll
                for (int c = 0; c < 8; ++c) { u32x2 w; w.x = cvt_pk_bf16(v[c][0], v[c][1]); w.y = cvt_pk_bf16(v[c][2], v[c][3]); *(u32x2*)(XB + (size_t)m * DM + c * 256 + lane * 4) = w; }
            }
        } else if (step == 3) {
            const float C2 = 0.08838834764831845f * LOG2E;
            { LAS float* GLw = (LAS float*)(lds + A_GL); if (tid < 128) GLw[tid] = p.fox_q_g[tid] * p.fox_k_g[tid]; __syncthreads(); }
            for (int L = vcu; L < 512; L += G) {
                const int i = L >> 8, c = L & 255, b = c >> 6, h8 = (c >> 3) & 7, pp = c & 7, hh = i * 8 + h8;
                const size_t hoff = (size_t)b * SEQ * DM + hh * 128;
                for (int pass = 0; pass < 2; ++pass) {
                    const int qb = pass ? pp : 15 - pp;
#ifndef NO_SB
                    if (i == 0) attn_unit<0>((LAS char*)lds, Q0 + hoff, DM, K0 + hoff, DM, V0 + hoff, DM, AO0 + hoff, DM, nullptr, qb, C2, nullptr, nullptr, nullptr, 0, nullptr, nullptr, nullptr, true);
#endif
#ifndef NO_FOX
                    if (i != 0) attn_unit<1>((LAS char*)lds, Q0 + hoff, DM, K0 + hoff, DM, V0 + hoff, DM, AO0 + hoff, DM, F2 + (size_t)(b * 8 + h8) * SEQ, qb, C2,
                                             p.fox_q_g, p.fox_k_g, KSS0 + (size_t)b * SEQ * 8 + h8, 8, nullptr, nullptr, nullptr, pass == 0);
#endif
                }
            }
        } else if (step == 11) {
            const float C2 = 0.07216878364870322f * LOG2E;
            { LAS float* GLw = (LAS float*)(lds + A_GL); if (tid < 192) GLw[tid] = p.mla_q_g[tid] * (tid < 128 ? p.mla_k_g[tid] : 1.0f);
              if (tid < 32) GLw[512 + tid] = exp2f(-(float)tid * (13.287712379549449f / 32.0f)); __syncthreads(); }
            for (int L = vcu; L < 512; L += G) {
                const int i = L >> 8, c = L & 255, b = c >> 6, h8 = (c >> 3) & 7, pp = c & 7, hh = i * 8 + h8;
                const size_t qoff = (size_t)b * SEQ * 3072 + hh * 192, voff = (size_t)b * SEQ * 2048 + hh * 128, rb = (size_t)b * SEQ;
                for (int pass = 0; pass < 2; ++pass) {
                    const int qb = pass ? pp : 15 - pp;
#ifndef NO_MLA
                    attn_unit<2>((LAS char*)lds, Q1 + qoff, 3072, K1 + voff, 2048, V1 + voff, 2048, AO1 + voff, 2048, nullptr, qb, C2,
                                 p.mla_q_g, p.mla_k_g, KSS1 + rb * 16 + hh, 16, SSPE + rb, p.pos + rb, KPR + rb * 64, pass == 0);
#endif
                }
            }
        } else {
            if (step == 1) {
                if (bx < 32) {
                    const float* src = LF + (size_t)bx * SEQ; float* dst = F2 + (size_t)bx * SEQ;
                    const f32x4 a = *(const f32x4*)(src + tid * 8), b = *(const f32x4*)(src + tid * 8 + 4);
                    float v[8] = {a[0], a[1], a[2], a[3], b[0], b[1], b[2], b[3]};
#pragma unroll
                    for (int e = 1; e < 8; ++e) v[e] += v[e - 1];
                    const float total = v[7]; float incl = total;
#pragma unroll
                    for (int o = 1; o < 64; o <<= 1) { const float t = __shfl_up(incl, o); if (lane >= o) incl += t; }
                    LAS float* wt = (LAS float*)lds;
                    if (lane == 63) wt[wave] = incl;
                    __syncthreads();
                    float base = incl - total;
                    for (int w = 0; w < wave; ++w) base += wt[w];
                    f32x4 oa = {v[0] + base, v[1] + base, v[2] + base, v[3] + base}, ob = {v[4] + base, v[5] + base, v[6] + base, v[7] + base};
                    *(f32x4*)(dst + tid * 8) = oa; *(f32x4*)(dst + tid * 8 + 4) = ob;
                }
                __syncthreads();
            }
            if (step == 8) {
                for (int idx = bx * 512 + tid; idx < M * 32; idx += G * 512) {
                    const int m = idx >> 5, i = idx & 31;
                    const float a = KPE[(size_t)m * 64 + i], b = KPE[(size_t)m * 64 + 32 + i];
                    float ss = a * a + b * b;
                    ss += __shfl_xor(ss, 16); ss += __shfl_xor(ss, 8); ss += __shfl_xor(ss, 4); ss += __shfl_xor(ss, 2); ss += __shfl_xor(ss, 1);
                    if (i == 0) SSPE[m] = ss;
                    const float ta = a * p.mla_k_g[128 + i], tb = b * p.mla_k_g[160 + i];
                    const float inv = exp2f(-(float)i * (13.287712379549449f / 32.0f));
                    const float ang = (float)p.pos[m] * inv;
                    const float kq = rintf(ang * 0.15915494309189535f);
                    float rr = fmaf(-kq, 6.28125f, ang); rr = fmaf(-kq, 1.9353071795864769e-3f, rr);
                    const float sn = __sinf(rr), cs = __cosf(rr);
                    const float o1 = ta * cs - tb * sn, o2 = tb * cs + ta * sn;
                    KPR[(size_t)m * 64 + i] = (bf16_t)(cvt_pk_bf16(o1, o1) & 0xffffu);
                    KPR[(size_t)m * 64 + 32 + i] = (bf16_t)(cvt_pk_bf16(o2, o2) & 0xffffu);
                }
            }
            pg8::Gemm g; pg8::Epi E;
            E.kind = pg8::K_PLAIN; E.last = 0; E.d0 = nullptr; E.d1 = nullptr; E.d2 = nullptr; E.ldc = 0; E.rs = RS0; E.invn = 1.0f / DM;
            E.xold = nullptr; E.xout = nullptr; E.xb = XB; E.rsn = nullptr; E.kpe = KPE; E.rsq = RSQ; E.rskv = RSKV; E.kss = (step == 1) ? KSS0 : KSS1;
            g.M = M; g.A = XB; g.Bt = nullptr; g.N = 0; g.K = DM;
            switch (step) {
                case 1:  g.A = XB; g.Bt = (const bf16_t*)(ws + WS_WIN); g.N = 6144; g.K = 2048; E.kind = pg8::K_IN; E.d0 = Q0; E.d1 = K0; E.d2 = V0; E.rs = RS0; break;
                case 4:  g.A = AO0; g.Bt = (const bf16_t*)(ws + WS_WO0); g.N = 2048; g.K = 2048; E.kind = pg8::K_RES; E.xold = p.x; E.xout = p.out; E.rsn = RS1; break;
                case 5:  g.A = XB; g.Bt = (const bf16_t*)(ws + WS_WUP0); g.N = 8192; g.K = 2048; E.kind = pg8::K_UP; E.d0 = HB; E.ldc = DFF; E.rs = RS1; break;
                case 6:  g.A = HB; g.Bt = (const bf16_t*)(ws + WS_WDN0); g.N = 2048; g.K = 8192; E.kind = pg8::K_RES; E.xold = p.out; E.xout = p.out; E.rsn = RS2; break;
                case 7:  g.A = XB; g.Bt = (const bf16_t*)(ws + WS_WMD); g.N = 1280; g.K = 2048; E.kind = pg8::K_MDOWN; E.d0 = CQ; E.d1 = CKV; E.rs = RS2; break;
                case 8:  g.A = CQ; g.Bt = (const bf16_t*)(ws + WS_WUQ); g.N = 3072; g.K = 512; E.kind = pg8::K_PLAIN; E.d0 = Q1; E.ldc = 3072; E.rs = RSQ; E.invn = 1.0f / 512.f; break;
                case 9:  g.A = CKV; g.Bt = (const bf16_t*)(ws + WS_WUKV); g.N = 4096; g.K = 512; E.kind = pg8::K_UKV; E.d0 = K1; E.d1 = V1; E.rs = RSKV; E.invn = 1.0f / 512.f; break;
                case 12: g.A = AO1; g.Bt = (const bf16_t*)(ws + WS_WO1); g.N = 2048; g.K = 2048; E.kind = pg8::K_RES; E.xold = p.out; E.xout = p.out; E.rsn = RS3; break;
                case 13: g.A = XB; g.Bt = (const bf16_t*)(ws + WS_WUP1); g.N = 8192; g.K = 2048; E.kind = pg8::K_UP; E.d0 = HB; E.ldc = DFF; E.rs = RS3; break;
                default: g.A = HB; g.Bt = (const bf16_t*)(ws + WS_WDN1); g.N = 2048; g.K = 8192; E.kind = pg8::K_RES; E.xold = p.out; E.xout = p.out; E.rsn = RS3; E.last = 1; break;
            }
            pg8::StaticOrder S; S.init(M, g.N, G, bx);
#ifndef NO_GEMM
            pg8::gemm_phase<pg8::Epi, pg8::StaticOrder>(lds, g, S, E);
#endif
        }
        }
        if (step != 8 && step != 14) xcd_barrier(xbar);
    }
}

extern "C" void kernel_launch(void* const* d_in, const int* in_sizes, int n_in, void* d_out, int out_size, void* d_ws, size_t ws_size, hipStream_t stream) {
    static int grid_blocks = 0;
    if (grid_blocks == 0) {
        if (n_in != 19 || ws_size < WS_END || out_size != M * DM) { fprintf(stderr, "kernel_launch: unexpected shapes (n_in %d, ws %zu, out %d)\n", n_in, ws_size, out_size); grid_blocks = -1; return; }
        int dev = 0, cus = 0, per_cu = 0;
        (void)hipGetDevice(&dev);
        (void)hipDeviceGetAttribute(&cus, hipDeviceAttributeMultiprocessorCount, dev);
        (void)hipFuncSetAttribute((const void*)mega_fwd, hipFuncAttributeMaxDynamicSharedMemorySize, LDS_BYTES);
        if (hipOccupancyMaxActiveBlocksPerMultiprocessor(&per_cu, (const void*)mega_fwd, 512, LDS_BYTES) != hipSuccess || per_cu < 1) per_cu = 1;
        (void)hipGetLastError();
        grid_blocks = cus * per_cu;
    }
    if (grid_blocks < 0) return;
    Params p{};
    p.x = (const float*)d_in[0]; p.pos = (const int*)d_in[1]; p.ln_mix_g = (const float*)d_in[2]; p.ln_mlp_g = (const float*)d_in[3]; p.w_in = (const float*)d_in[4];
    p.b_f = (const float*)d_in[5]; p.fox_q_g = (const float*)d_in[6]; p.fox_k_g = (const float*)d_in[7]; p.w_o0 = (const float*)d_in[8]; p.mla_w_down = (const float*)d_in[9];
    p.q_a_g = (const float*)d_in[10]; p.kv_a_g = (const float*)d_in[11]; p.w_uq = (const float*)d_in[12]; p.w_ukv = (const float*)d_in[13]; p.mla_q_g = (const float*)d_in[14];
    p.mla_k_g = (const float*)d_in[15]; p.w_o1 = (const float*)d_in[16]; p.w_up = (const float*)d_in[17]; p.w_dn = (const float*)d_in[18];
    p.out = (float*)d_out; p.ws = (unsigned char*)d_ws;
    (void)hipMemsetAsync((unsigned char*)d_ws + WS_BAR, 0, 16384, stream);
    void* args[] = {&p};
    hipError_t e = hipLaunchCooperativeKernel((const void*)mega_fwd, dim3(grid_blocks), dim3(512), args, LDS_BYTES, stream);
    if (e != hipSuccess) fprintf(stderr, "cooperative launch failed: %s (grid %d)\n", hipGetErrorString(e), grid_blocks);
}
```

```cpp
#include <hip/hip_runtime.h>
#include <hip/hip_cooperative_groups.h>
#include <cstdio>
#include <cstdint>
namespace cg = cooperative_groups;

#define LAS __attribute__((address_space(3)))
#define GAS __attribute__((address_space(1)))
typedef unsigned short bf16_t;
typedef short bf16x8 __attribute__((ext_vector_type(8)));
typedef short s16x4 __attribute__((ext_vector_type(4)));
typedef float f32x4 __attribute__((ext_vector_type(4)));
typedef float f32x16 __attribute__((ext_vector_type(16)));
typedef unsigned u32x4 __attribute__((ext_vector_type(4)));
typedef unsigned u32x2 __attribute__((ext_vector_type(2)));

constexpr int NB = 4, SEQ = 4096, M = NB * SEQ, DM = 2048, DFF = 8192, INW = 6152;
constexpr float EPS = 1e-6f;
constexpr float LOG2E = 1.4426950408889634f;
constexpr size_t MiB = 1u << 20;
constexpr size_t WS_RS = 0;
constexpr size_t WS_LF = 512 * 1024, WS_F2 = 1 * MiB, WS_KPE = 2 * MiB, WS_BAR = 6 * MiB, WS_KSS0 = 6 * MiB + 512 * 1024, WS_KSS1 = 7 * MiB;
constexpr size_t WS_WIN = 8 * MiB, WS_WO0 = 32 * MiB, WS_WUP0 = 40 * MiB, WS_WDN0 = 72 * MiB;
constexpr size_t WS_CQ = 8 * MiB, WS_CKV = 24 * MiB, WS_AO1 = 40 * MiB;
constexpr size_t WS_WMD = 104 * MiB, WS_WUQ = 109 * MiB, WS_WUKV = 112 * MiB, WS_WO1 = 116 * MiB, WS_WUP1 = 124 * MiB, WS_WDN1 = 156 * MiB;
constexpr size_t WS_XB = 188 * MiB;
constexpr size_t WS_BIG = 252 * MiB;
constexpr size_t WS_Q0 = WS_BIG, WS_K0 = WS_BIG + 64 * MiB, WS_V0 = WS_BIG + 128 * MiB, WS_AO0 = WS_BIG + 192 * MiB, WS_H = WS_BIG;
constexpr size_t WS_Q1 = WS_BIG, WS_K1 = WS_BIG + 96 * MiB, WS_V1 = WS_BIG + 160 * MiB;
constexpr size_t WS_KPR = 508 * MiB, WS_SSPE = 510 * MiB;
constexpr size_t WS_END = 511 * MiB;
constexpr int LDS_BYTES = 147456;
#ifndef DUP_MASK
#define DUP_MASK 0
#endif

__device__ __forceinline__ unsigned cvt_pk_bf16(float lo, float hi) { unsigned r; asm volatile("v_cvt_pk_bf16_f32 %0, %1, %2" : "=v"(r) : "v"(lo), "v"(hi)); return r; }
__device__ __forceinline__ float bf2f(short s) { return __uint_as_float(((unsigned)(unsigned short)s) << 16); }
__device__ __forceinline__ float wave_sum(float v) {
#pragma unroll
    for (int o = 1; o < 64; o <<= 1) v += __shfl_xor(v, o);
    return v;
}

namespace pg8 {
constexpr int BM = 256, BK = 64, HALF = 128, HTB = HALF * BK * 2, STAGE_BYTES = 8 * HTB, NXCD = 8, WGM = 4;
__host__ __device__ __forceinline__ int lds_byte(int r, int c) { const int st = (r >> 4) * 2 + (c >> 5), rr = r & 15, cc = c & 31, ob = rr * 64 + cc * 2; return st * 1024 + (ob ^ (((ob >> 9) & 1) << 5)); }
__host__ __device__ __forceinline__ void stage_rc(int b, int& R, int& C) { const int st = b / 1024, sb = b % 1024, swz = sb ^ (((sb >> 9) & 1) << 5); R = (st >> 1) * 16 + swz / 64; C = (st & 1) * 32 + (swz % 64) / 2; }
__host__ __device__ __forceinline__ int perm32(int rho) { const int n = rho >> 4, i = rho & 15; return 8 * (i >> 2) + 4 * n + (i & 3); }
struct Unit { int pm, pn; };
struct Gemm { const bf16_t* A; const bf16_t* Bt; int M, N, K; };
struct StaticOrder {
    int nM, nN, nwg, G, c;
    __host__ __device__ void init(int M_, int N_, int G_, int c_) { nM = M_ / BM; nN = N_ / BM; nwg = nM * nN; G = G_; c = c_; }
    __host__ __device__ bool next(int i, Unit& u) const {
        const long L = (long)i * G + c; if (L >= nwg) return false;
        int wgid = (int)L; { const int q = nwg / NXCD, r = nwg % NXCD, xcd = wgid % NXCD, off = wgid / NXCD; wgid = (xcd < r ? xcd * (q + 1) : r * (q + 1) + (xcd - r) * q) + off; }
        const int nig = WGM * nN, gid = wgid / nig, fm = gid * WGM, gsz = (nM - fm) < WGM ? (nM - fm) : WGM;
        u.pm = fm + ((wgid % nig) % gsz); u.pn = (wgid % nig) / gsz; return true;
    }
};

enum { K_IN = 0, K_PLAIN = 1, K_UP = 2, K_UKV = 3, K_RES = 4, K_MDOWN = 5 };
struct Epi {
    static constexpr bool PERM = true;
    int kind; int last;
    bf16_t* d0; bf16_t* d1; bf16_t* d2; int ldc;
    const float* rs; float invn;
    const float* xold; float* xout; bf16_t* xb; float* rsn;
    float* kpe; float* rsq; float* rskv; float* kss;
    __device__ __forceinline__ void operator()(const f32x4 (&acc)[2][2][4][2], const Unit& u, int wr, int wc, int fr, int fq) const {
        const int row0 = u.pm * BM + wr * 64 + fr; const int lc = wc * 32 + 8 * fq;
        if (kind == K_RES) {
#pragma unroll
            for (int ai = 0; ai < 2; ++ai) {
                u32x4 xo[4][2];
#pragma unroll
                for (int m = 0; m < 4; ++m)
#pragma unroll
                    for (int bj = 0; bj < 2; ++bj)
                        xo[m][bj] = *(const GAS u32x4*)(xb + (size_t)(row0 + ai * HALF + m * 16) * DM + u.pn * BM + bj * HALF + lc);
                asm volatile("" ::: "memory");
#pragma unroll
                for (int m = 0; m < 4; ++m) {
                    const int row = row0 + ai * HALF + m * 16; float ss = 0.f;
#pragma unroll
                    for (int bj = 0; bj < 2; ++bj) {
                        const size_t off = (size_t)row * DM + u.pn * BM + bj * HALF + lc; const u32x4 x = xo[m][bj];
                        f32x4 a = {__uint_as_float(x.x << 16), __uint_as_float(x.x & 0xffff0000u), __uint_as_float(x.y << 16), __uint_as_float(x.y & 0xffff0000u)};
                        f32x4 b = {__uint_as_float(x.z << 16), __uint_as_float(x.z & 0xffff0000u), __uint_as_float(x.w << 16), __uint_as_float(x.w & 0xffff0000u)};
                        a += acc[ai][bj][m][0]; b += acc[ai][bj][m][1];
                        if (!last) {
                            ss += (a[0] * a[0] + a[1] * a[1]) + (a[2] * a[2] + a[3] * a[3]) + (b[0] * b[0] + b[1] * b[1]) + (b[2] * b[2] + b[3] * b[3]);
                            u32x4 w; w.x = cvt_pk_bf16(a[0], a[1]); w.y = cvt_pk_bf16(a[2], a[3]); w.z = cvt_pk_bf16(b[0], b[1]); w.w = cvt_pk_bf16(b[2], b[3]);
                            *(GAS u32x4*)(xb + off) = w;
                        } else { *(GAS f32x4*)(xout + off) = a; *(GAS f32x4*)(xout + off + 4) = b; }
                    }
                    if (!last) { ss += __shfl_xor(ss, 16); ss += __shfl_xor(ss, 32); if (fq == 0) __hip_atomic_fetch_add((GAS float*)(rsn + row), ss, __ATOMIC_RELAXED, __HIP_MEMORY_SCOPE_AGENT); }
                }
                asm volatile("" ::: "memory");
            }
            return;
        }
        if (kind == K_MDOWN && u.pn == 4) {
            if (wc < 2) {
#pragma unroll
                for (int ai = 0; ai < 2; ++ai)
#pragma unroll
                    for (int m = 0; m < 4; ++m) {
                        const int row = row0 + ai * HALF + m * 16; const float sc = 1.0f / sqrtf(*(const GAS float*)(rs + row) * invn + EPS);
                        float* o = kpe + (size_t)row * 64 + lc;
                        *(GAS f32x4*)o = acc[ai][0][m][0] * sc; *(GAS f32x4*)(o + 4) = acc[ai][0][m][1] * sc;
                    }
            }
            return;
        }
        bf16_t* p0; bf16_t* p1; int ld0, ld1; float* ssd = nullptr; float* hs0 = nullptr; float* hs1 = nullptr; int hld = 0;
        if (kind == K_IN) { const int grp = u.pn >> 2, buf = grp % 3; bf16_t* base = d0 + (size_t)buf * (32u << 20);
            p0 = base + (grp / 3) * 1024 + (u.pn & 3) * 256 + lc; p1 = p0 + HALF; ld0 = ld1 = DM;
            if (grp == 4) { hs0 = kss + 2 * (u.pn & 3); hs1 = hs0 + 1; hld = 8; } }
        else if (kind == K_UKV) { p0 = d0 + u.pn * 128 + lc; ld0 = 2048; p1 = d1 + u.pn * 128 + lc; ld1 = 2048; hs0 = kss + u.pn; hld = 16; }
        else if (kind == K_MDOWN) { bf16_t* base = d0 + (size_t)(u.pn >> 1) * (8u << 20); p0 = base + (u.pn & 1) * 256 + lc; p1 = p0 + HALF; ld0 = ld1 = 512; ssd = rsq + (size_t)(u.pn >> 1) * M; }
        else { p0 = d0 + u.pn * BM + lc; p1 = p0 + HALF; ld0 = ld1 = ldc; }
        const bool act = (kind == K_UP);
        float rsv[8];
#pragma unroll
        for (int i = 0; i < 8; ++i) rsv[i] = *(const GAS float*)(rs + row0 + (i >> 2) * HALF + (i & 3) * 16);
#pragma unroll
        for (int ai = 0; ai < 2; ++ai)
#pragma unroll
            for (int m = 0; m < 4; ++m) {
                const int row = row0 + ai * HALF + m * 16; const float sc = 1.0f / sqrtf(rsv[ai * 4 + m] * invn + EPS); float ssb[2];
#pragma unroll
                for (int bj = 0; bj < 2; ++bj) {
                    f32x4 a = acc[ai][bj][m][0] * sc, b = acc[ai][bj][m][1] * sc;
                    if (act) {
#pragma unroll
                        for (int e = 0; e < 4; ++e) { const float x = fmaxf(a[e], 0.f), y = fmaxf(b[e], 0.f); a[e] = x * x; b[e] = y * y; }
                    }
                    ssb[bj] = (a[0] * a[0] + a[1] * a[1]) + (a[2] * a[2] + a[3] * a[3]) + (b[0] * b[0] + b[1] * b[1]) + (b[2] * b[2] + b[3] * b[3]);
                    u32x4 w; w.x = cvt_pk_bf16(a[0], a[1]); w.y = cvt_pk_bf16(a[2], a[3]); w.z = cvt_pk_bf16(b[0], b[1]); w.w = cvt_pk_bf16(b[2], b[3]);
                    bf16_t* dst = bj == 0 ? p0 + (size_t)row * ld0 : p1 + (size_t)row * ld1;
                    *(GAS u32x4*)dst = w;
                }
                if (hs0) { float t0 = ssb[0]; t0 += __shfl_xor(t0, 16); t0 += __shfl_xor(t0, 32); if (fq == 0) __hip_atomic_fetch_add((GAS float*)(hs0 + (size_t)row * hld), t0, __ATOMIC_RELAXED, __HIP_MEMORY_SCOPE_AGENT); }
                if (hs1) { float t1 = ssb[1]; t1 += __shfl_xor(t1, 16); t1 += __shfl_xor(t1, 32); if (fq == 0) __hip_atomic_fetch_add((GAS float*)(hs1 + (size_t)row * hld), t1, __ATOMIC_RELAXED, __HIP_MEMORY_SCOPE_AGENT); }
                const float ss = ssb[0] + ssb[1];
                if (ssd) { float t2 = ss; t2 += __shfl_xor(t2, 16); t2 += __shfl_xor(t2, 32); if (fq == 0) __hip_atomic_fetch_add((GAS float*)(ssd + row), t2, __ATOMIC_RELAXED, __HIP_MEMORY_SCOPE_AGENT); }
            }
    }
};

template <class EpiT, class Sched>
__device__ __forceinline__ void gemm_phase(LAS unsigned char* lds, const Gemm g, const Sched& S, const EpiT& E) {
    int tid_l = threadIdx.x; asm volatile("" : "+v"(tid_l));
    const int tid = tid_l, wid = __builtin_amdgcn_readfirstlane(tid >> 6), lane = tid & 63, wr = wid >> 2, wc = wid & 3, fr = lane & 15, fq = lane >> 4;
    const int K = g.K, nt = K / BK;
    unsigned voffA[2], voffB[2];
#pragma unroll
    for (int i = 0; i < 2; ++i) { int R, C; stage_rc(tid * 16 + i * 8192, R, C); const int Rb = EpiT::PERM ? ((R & ~31) + perm32(R & 31)) : R;
        voffA[i] = (unsigned)(R * K + C) * 2u; voffB[i] = (unsigned)(Rb * K + C) * 2u; }
    const size_t kstep = (size_t)(BK * 2);
    const size_t hstep = (size_t)HALF * K * 2;
    const size_t tstep = 2 * hstep;
    const unsigned ldsw = (unsigned)wid * 1024u;
    const int aoff = lds_byte(wr * 64 + fr, fq * 8), boff = lds_byte(wc * 32 + fr, fq * 8);
#define PG8_SA(b, h) (((b) * 2 + (h)) * HTB)
#define PG8_SB(b, h) ((4 + (b) * 2 + (h)) * HTB)
#define PG8_STAGE(bufoff, gbase, voff) do { _Pragma("unroll") for (int _i = 0; _i < 2; ++_i) \
        __builtin_amdgcn_global_load_lds((const unsigned*)((const char*)(gbase) + (voff)[_i]), (LAS unsigned*)(lds + (bufoff) + ldsw + _i * 8192), 16, 0, 0); } while (0)
#define PG8_LDA(dst, b, h) do { _Pragma("unroll") for (int m = 0; m < 4; ++m) _Pragma("unroll") for (int k = 0; k < 2; ++k) dst[m][k] = *(const LAS bf16x8*)(lds + PG8_SA(b, h) + aoff + m * 2048 + k * 1024); } while (0)
#define PG8_LDB(dst, b, h) do { _Pragma("unroll") for (int n = 0; n < 2; ++n) _Pragma("unroll") for (int k = 0; k < 2; ++k) dst[n][k] = *(const LAS bf16x8*)(lds + PG8_SB(b, h) + boff + n * 2048 + k * 1024); } while (0)
#define PG8_MMA(ai, bj, At, Bt) do { __builtin_amdgcn_s_setprio(1); _Pragma("unroll") for (int m = 0; m < 4; ++m) _Pragma("unroll") for (int n = 0; n < 2; ++n) _Pragma("unroll") for (int k = 0; k < 2; ++k) \
        acc[ai][bj][m][n] = __builtin_amdgcn_mfma_f32_16x16x32_bf16(Bt[n][k], At[m][k], acc[ai][bj][m][n], 0, 0, 0); __builtin_amdgcn_s_setprio(0); } while (0)
#define PG8_WAIT_V(n) asm volatile("s_waitcnt vmcnt(" #n ")" ::: "memory")
#define PG8_WAIT_L(n) asm volatile("s_waitcnt lgkmcnt(" #n ")" ::: "memory")
#define PG8_BAR __builtin_amdgcn_s_barrier()
#define PG8_SCHED __builtin_amdgcn_sched_barrier(0)
    Unit cur, nxt; int ui = 0;
    if (!S.next(0, cur)) return;
    f32x4 acc[2][2][4][2];
#pragma unroll
    for (int a = 0; a < 2; ++a)
#pragma unroll
        for (int b = 0; b < 2; ++b)
#pragma unroll
            for (int m = 0; m < 4; ++m)
#pragma unroll
                for (int n = 0; n < 2; ++n) acc[a][b][m][n] = (f32x4){0.f, 0.f, 0.f, 0.f};
    bf16x8 At[4][2], B0[2][2], B1[2][2];
    const char* cA = (const char*)g.A + (size_t)cur.pm * tstep; const char* cB = (const char*)g.Bt + (size_t)cur.pn * tstep;
    {
        PG8_STAGE(PG8_SB(0, 0), cB, voffB); PG8_STAGE(PG8_SB(0, 1), cB + hstep, voffB); PG8_STAGE(PG8_SA(0, 0), cA, voffA); PG8_STAGE(PG8_SA(0, 1), cA + hstep, voffA);
        if (wr == 1) PG8_BAR;
        PG8_WAIT_V(2); PG8_BAR;
        PG8_STAGE(PG8_SB(1, 0), cB + kstep, voffB); PG8_STAGE(PG8_SA(1, 0), cA + kstep, voffA); PG8_STAGE(PG8_SB(1, 1), cB + hstep + kstep, voffB);
        PG8_WAIT_V(6); PG8_BAR;
    }
    for (;;) {
        const bool has_next = S.next(ui + 1, nxt);
        const char* nA = has_next ? (const char*)g.A + (size_t)nxt.pm * tstep : cA; const char* nB = has_next ? (const char*)g.Bt + (size_t)nxt.pn * tstep : cB;
        for (int t = 0; t < nt; t += 2) {
            const bool last = (t == nt - 2);
            const char* a1 = cA + (size_t)(t + 1) * kstep;
            const char* a2 = last ? nA : cA + (size_t)(t + 2) * kstep; const char* b2 = last ? nB : cB + (size_t)(t + 2) * kstep;
            const char* a3 = a2 + kstep; const char* b3 = b2 + kstep;
            PG8_LDB(B0, 0, 0); PG8_LDB(B1, 0, 1); PG8_SCHED; PG8_LDA(At, 0, 0); PG8_STAGE(PG8_SA(1, 1), a1 + hstep, voffA);
            PG8_WAIT_V(8); PG8_WAIT_L(0); PG8_BAR; PG8_MMA(0, 0, At, B0); PG8_MMA(0, 1, At, B1); PG8_BAR; PG8_SCHED;
            PG8_LDA(At, 0, 1); PG8_STAGE(PG8_SB(0, 0), b2, voffB); PG8_STAGE(PG8_SB(0, 1), b2 + hstep, voffB); PG8_STAGE(PG8_SA(0, 0), a2, voffA);
            PG8_WAIT_V(8); PG8_WAIT_L(0); PG8_BAR; PG8_MMA(1, 0, At, B0); PG8_MMA(1, 1, At, B1); PG8_BAR; PG8_SCHED;
            PG8_LDB(B0, 1, 0); PG8_LDB(B1, 1, 1); PG8_SCHED; PG8_LDA(At, 1, 0); PG8_STAGE(PG8_SA(0, 1), a2 + hstep, voffA);
            PG8_WAIT_V(8); PG8_WAIT_L(0); PG8_BAR; PG8_MMA(0, 0, At, B0); PG8_MMA(0, 1, At, B1); PG8_BAR; PG8_SCHED;
            PG8_LDA(At, 1, 1); PG8_STAGE(PG8_SB(1, 0), b3, voffB); PG8_STAGE(PG8_SB(1, 1), b3 + hstep, voffB); PG8_STAGE(PG8_SA(1, 0), a3, voffA);
            PG8_WAIT_V(8); PG8_WAIT_L(0); PG8_BAR; PG8_MMA(1, 0, At, B0); PG8_MMA(1, 1, At, B1); PG8_BAR; PG8_SCHED;
        }
        if (wr == 0) PG8_BAR;
        E(acc, cur, wr, wc, fr, fq);
        if (!has_next) break;
#pragma unroll
        for (int a = 0; a < 2; ++a)
#pragma unroll
            for (int b = 0; b < 2; ++b)
#pragma unroll
                for (int m = 0; m < 4; ++m)
#pragma unroll
                    for (int n = 0; n < 2; ++n) acc[a][b][m][n] = (f32x4){0.f, 0.f, 0.f, 0.f};
        cur = nxt; cA = nA; cB = nB; ++ui;
        if (wr == 1) PG8_BAR;
    }
    PG8_WAIT_V(0);
    PG8_BAR;
#undef PG8_SA
#undef PG8_SB
#undef PG8_STAGE
#undef PG8_LDA
#undef PG8_LDB
#undef PG8_MMA
#undef PG8_WAIT_V
#undef PG8_WAIT_L
#undef PG8_BAR
#undef PG8_SCHED
}
}

#define KSWZ(row, colB) ((row) * 256 + ((colB) ^ (((row) & 15) << 4)))
#define PSWZ(row, colB) ((row) * 128 + ((colB) ^ ((((row) >> 1) & 7) << 4)))
#define SBAR() __builtin_amdgcn_sched_barrier(0)
#ifndef QK_DEP_MLA
#define QK_DEP_MLA 3
#endif
constexpr int A_V = 0, A_K = 49152, A_P = 81920, A_F = 98304, A_W = 99840, A_FLG = 101888, A_END = 101904, A_GL = 102400, A_RK = 105472, A_F2L = 121856;
__device__ __forceinline__ int v_st(int k, int c) { const int kk = (k & ~0xC) | ((k & 4) << 1) | ((k & 8) >> 1); return ((kk >> 3) * 4 + (c >> 5)) * 512 + ((kk & 7) * 32 + (c & 31)) * 2; }
__device__ __forceinline__ int v_rd_base(int lane) { return ((lane & 3) << 3) | (((lane >> 2) & 3) << 6) | (((lane >> 4) & 1) << 5) | (((lane >> 5) & 1) << 8); }
__device__ __forceinline__ int crow(int r, int hi) { return (r & 3) + 8 * (r >> 2) + 4 * hi; }
__device__ __forceinline__ float swap_sum(float v) { auto rr = __builtin_amdgcn_permlane32_swap(__float_as_uint(v), __float_as_uint(v), false, false); return __uint_as_float(rr[0]) + __uint_as_float(rr[1]); }
__device__ __forceinline__ float swap_max(float v) { auto rr = __builtin_amdgcn_permlane32_swap(__float_as_uint(v), __float_as_uint(v), false, false); return fmaxf(__uint_as_float(rr[0]), __uint_as_float(rr[1])); }

#define PK4(P, B_, OUT) do { unsigned a0 = cvt_pk_bf16(P[B_+0], P[B_+1]), a1 = cvt_pk_bf16(P[B_+2], P[B_+3]);                          \
        unsigned b0 = cvt_pk_bf16(P[B_+4], P[B_+5]), b1 = cvt_pk_bf16(P[B_+6], P[B_+7]);                                             \
        auto r0 = __builtin_amdgcn_permlane32_swap(a0, b0, false, false); auto r1 = __builtin_amdgcn_permlane32_swap(a1, b1, false, false); \
        u32x4 w = {r0[0], r1[0], r0[1], r1[1]}; OUT = __builtin_bit_cast(bf16x8, w); } while (0)

template <int MODE>
__device__ __forceinline__ void qkt(f32x16& p0, f32x16& p1, LAS const char* K_lds, LAS const char* P_lds, int kbuf, int r32, int hi, const bf16x8* qr) {
    constexpr int ND = (MODE == 2) ? 12 : 8, DEP = (MODE == 2) ? QK_DEP_MLA : 4;
    LAS const char* kbase = K_lds + kbuf * 16384;
    LAS const char* pbase = P_lds + kbuf * 8192;
    LAS const char* kb[4]; LAS const char* pb[4];
#pragma unroll
    for (int dd = 0; dd < 4; ++dd) { kb[dd] = kbase + KSWZ(r32, (dd * 16 + hi * 8) * 2); pb[dd] = pbase + PSWZ(r32, (dd * 16 + hi * 8) * 2); }
    bf16x8 kf[2 * DEP];
#define QK_LD(d, slot) do { if ((d) < 8) { LAS const char* a_ = ((d) < 4) ? kb[(d) & 3] : (LAS const char*)((unsigned)(size_t)kb[(d) & 3] ^ 128u); kf[2 * (slot)] = *(LAS const bf16x8*)a_; kf[2 * (slot) + 1] = *(LAS const bf16x8*)(a_ + 32 * 256); } \
                            else { LAS const char* a_ = pb[((d) - 8) & 3]; kf[2 * (slot)] = *(LAS const bf16x8*)a_; kf[2 * (slot) + 1] = *(LAS const bf16x8*)(a_ + 32 * 128); } } while (0)
#pragma unroll
    for (int d = 0; d < DEP; ++d) QK_LD(d, d);
    SBAR();
    const f32x16 zero = {0.f, 0.f, 0.f, 0.f, 0.f, 0.f, 0.f, 0.f, 0.f, 0.f, 0.f, 0.f, 0.f, 0.f, 0.f, 0.f};
#pragma unroll
    for (int d = 0; d < ND; ++d) {
        const int slot = d % DEP;
        if (d == 0) { p0 = __builtin_amdgcn_mfma_f32_32x32x16_bf16(kf[0], qr[0], zero, 0, 0, 0); p1 = __builtin_amdgcn_mfma_f32_32x32x16_bf16(kf[1], qr[0], zero, 0, 0, 0); }
        else { p0 = __builtin_amdgcn_mfma_f32_32x32x16_bf16(kf[2 * slot], qr[d], p0, 0, 0, 0); p1 = __builtin_amdgcn_mfma_f32_32x32x16_bf16(kf[2 * slot + 1], qr[d], p1, 0, 0, 0); }
        if (d + DEP < ND) QK_LD(d + DEP, slot);
        SBAR();
    }
#undef QK_LD
}
__device__ __forceinline__ void pv_tile(f32x16* o, int vb, bf16x8 pa0, bf16x8 pa1, bf16x8 pa2, bf16x8 pa3) {
#define TRRD(dst, off) asm volatile("ds_read_b64_tr_b16 %0, %1 offset:%2" : "=&v"(dst) : "v"(vb), "i"(off) : "memory")
#define PV_D0(d0) do { s16x4 l0, l1, l2, l3, h0, h1, h2, h3; constexpr int b_ = (d0) * 512; \
        TRRD(l0, b_); TRRD(h0, b_ + 2048); TRRD(l1, b_ + 4096); TRRD(h1, b_ + 6144); TRRD(l2, b_ + 8192); TRRD(h2, b_ + 10240); TRRD(l3, b_ + 12288); TRRD(h3, b_ + 14336); \
        asm volatile("s_waitcnt lgkmcnt(0)" ::: "memory"); SBAR();   \
        o[d0] = __builtin_amdgcn_mfma_f32_32x32x16_bf16(pa0, (bf16x8){l0[0], l0[1], l0[2], l0[3], h0[0], h0[1], h0[2], h0[3]}, o[d0], 0, 0, 0);   \
        o[d0] = __builtin_amdgcn_mfma_f32_32x32x16_bf16(pa1, (bf16x8){l1[0], l1[1], l1[2], l1[3], h1[0], h1[1], h1[2], h1[3]}, o[d0], 0, 0, 0);   \
        o[d0] = __builtin_amdgcn_mfma_f32_32x32x16_bf16(pa2, (bf16x8){l2[0], l2[1], l2[2], l2[3], h2[0], h2[1], h2[2], h2[3]}, o[d0], 0, 0, 0);   \
        o[d0] = __builtin_amdgcn_mfma_f32_32x32x16_bf16(pa3, (bf16x8){l3[0], l3[1], l3[2], l3[3], h3[0], h3[1], h3[2], h3[3]}, o[d0], 0, 0, 0); } while (0)
    PV_D0(0); PV_D0(1); PV_D0(2); PV_D0(3);
#undef PV_D0
#undef TRRD
}

template <int MODE>
__device__ __forceinline__ void attn_unit(LAS char* lds, const bf16_t* Qp, int ldq, const bf16_t* Kp, int ldk, const bf16_t* Vp, int ldv, bf16_t* Op, int ldo, const float* F2, int qb, float C2,
               const float* g1, const float* g2, const float* kss, int kss_ld, const float* sspe, const int* posb, const bf16_t* Kpe, bool fresh_tables) {
    constexpr int NQ = (MODE == 2) ? 12 : 8;
    int tid_l = threadIdx.x; asm volatile("" : "+v"(tid_l));
    const int tid = tid_l, wid = __builtin_amdgcn_readfirstlane(tid >> 6), lane = tid & 63, r32 = lane & 31, hi = lane >> 5;
    const bool grpB = wid >= 4;
    const int q0 = qb * 256, NT = 4 * qb + 4;
    const int qlo = q0 + wid * 32, tq = qlo + r32;
    LAS char* V_lds = lds + A_V; LAS char* K_lds = lds + A_K; LAS char* P_lds = lds + A_P; LAS float* F_lds = (LAS float*)(lds + A_F);
    LAS float* wsf = (LAS float*)(lds + A_W) + wid * 64; LAS float* li_l = wsf; LAS float* al_l = wsf + 32;
    LAS const float* GL = (LAS const float*)(lds + A_GL);
    const int sr = tid >> 4, sc = (tid & 15) * 8;
    const int vst0 = v_st(sr, sc), vst1 = v_st(32 + sr, sc), kws = KSWZ(sr, sc * 2);
    const int pr = tid >> 3, pc = (tid & 7) * 8, pws = PSWZ(pr, pc * 2);
    const int vb0 = (int)(size_t)V_lds + v_rd_base(lane);
    bf16x8 qr[NQ];
    {
        const bf16_t* qrow = Qp + (size_t)tq * ldq + hi * 8;
#pragma unroll
        for (int d0 = 0; d0 < NQ; ++d0) qr[d0] = *(const GAS bf16x8*)(qrow + d0 * 16);
    }
    float f2t = 0.f; if constexpr (MODE == 1) f2t = *(const GAS float*)(F2 + tq);
    bf16x8 st_k0, st_k1, st_v0, st_v1, st_kp;
#define JT(t) ((MODE == 0) ? (NT - 1 - (t)) : (t))
#define SLOAD(j) do { const int k0_ = (j) * 64; \
        st_k0 = *(const GAS bf16x8*)(Kp + (size_t)(k0_ + sr) * ldk + sc); st_k1 = *(const GAS bf16x8*)(Kp + (size_t)(k0_ + 32 + sr) * ldk + sc); \
        st_v0 = *(const GAS bf16x8*)(Vp + (size_t)(k0_ + sr) * ldv + sc); st_v1 = *(const GAS bf16x8*)(Vp + (size_t)(k0_ + 32 + sr) * ldv + sc); \
        if constexpr (MODE == 2) { st_kp = *(const GAS bf16x8*)(Kpe + (size_t)(k0_ + pr) * 64 + pc); } } while (0)
#define SWRITE(kbf, vbf) do { *(LAS bf16x8*)(K_lds + (kbf) * 16384 + kws) = st_k0; *(LAS bf16x8*)(K_lds + (kbf) * 16384 + kws + 32 * 256) = st_k1; \
        *(LAS bf16x8*)(V_lds + (vbf) * 16384 + vst0) = st_v0; *(LAS bf16x8*)(V_lds + (vbf) * 16384 + vst1) = st_v1; \
        if constexpr (MODE == 2) *(LAS bf16x8*)(P_lds + (kbf) * 8192 + pws) = st_kp; \
        } while (0)
    float m_reg = -1e30f, l_reg = 0.f, Rc = 0.f; bool wdone = false, stop = false, pend = false;
    int pj = 0, pv3 = 0;
    LAS int* flg = (LAS int*)(lds + A_FLG);
    if constexpr (MODE == 0) { if (tid < 4) flg[tid] = 0; }
    const float m0 = hi == 0 ? 1.f : 0.f;

    SLOAD(JT(0));
    LAS float* RK = (LAS float*)(lds + A_RK); LAS float* F2L = (LAS float*)(lds + A_F2L);
    if constexpr (MODE != 0) {
        if (fresh_tables) {
            const int nk = q0 + 256;
            float rv[8], sv[8], fv[8];
#pragma unroll
            for (int i = 0; i < 8; ++i) { const int k = tid + 512 * i; rv[i] = 1.f; sv[i] = 0.f; fv[i] = 0.f;
                if (k < nk) { rv[i] = *(const GAS float*)(kss + (size_t)k * kss_ld);
                    if constexpr (MODE == 2) sv[i] = *(const GAS float*)(sspe + k);
                    if constexpr (MODE == 1) fv[i] = *(const GAS float*)(F2 + k); } }
#pragma unroll
            for (int i = 0; i < 8; ++i) { const int k = tid + 512 * i;
                if (k < nk) { RK[k] = C2 / sqrtf((rv[i] + sv[i]) * ((MODE == 1) ? (1.0f / 128.f) : (1.0f / 192.f)) + EPS);
                    if constexpr (MODE == 1) F2L[k] = fv[i]; } }
        }
    }
    if constexpr (MODE == 1) {
        float ss = 0.f;
#pragma unroll
        for (int d0 = 0; d0 < 8; ++d0)
#pragma unroll
            for (int e = 0; e < 8; ++e) { const float f = bf2f(qr[d0][e]); ss += f * f; }
        ss = swap_sum(ss);
        const float rstd = 1.0f / sqrtf(ss * (1.0f / 128.f) + EPS);
#pragma unroll
        for (int d0 = 0; d0 < 8; ++d0) { const int d = d0 * 16 + hi * 8;
            const f32x4 ga = *(LAS const f32x4*)(GL + d), gb = *(LAS const f32x4*)(GL + d + 4);
            float f[8];
#pragma unroll
            for (int e = 0; e < 4; ++e) { f[e] = bf2f(qr[d0][e]) * rstd * ga[e]; f[4 + e] = bf2f(qr[d0][4 + e]) * rstd * gb[e]; }
            u32x4 w; w.x = cvt_pk_bf16(f[0], f[1]); w.y = cvt_pk_bf16(f[2], f[3]); w.z = cvt_pk_bf16(f[4], f[5]); w.w = cvt_pk_bf16(f[6], f[7]);
            qr[d0] = __builtin_bit_cast(bf16x8, w); }
    }
    if constexpr (MODE == 2) {
        float ss = 0.f;
#pragma unroll
        for (int d0 = 0; d0 < 12; ++d0)
#pragma unroll
            for (int e = 0; e < 8; ++e) { const float f = bf2f(qr[d0][e]); ss += f * f; }
        ss = swap_sum(ss);
        const float rstd = 1.0f / sqrtf(ss * (1.0f / 192.f) + EPS);
#pragma unroll
        for (int d0 = 0; d0 < 8; ++d0) { const int d = d0 * 16 + hi * 8;
            const f32x4 ga = *(LAS const f32x4*)(GL + d), gb = *(LAS const f32x4*)(GL + d + 4);
            float f[8];
#pragma unroll
            for (int e = 0; e < 4; ++e) { f[e] = bf2f(qr[d0][e]) * rstd * ga[e]; f[4 + e] = bf2f(qr[d0][4 + e]) * rstd * gb[e]; }
            u32x4 w; w.x = cvt_pk_bf16(f[0], f[1]); w.y = cvt_pk_bf16(f[2], f[3]); w.z = cvt_pk_bf16(f[4], f[5]); w.w = cvt_pk_bf16(f[6], f[7]);
            qr[d0] = __builtin_bit_cast(bf16x8, w); }
        const float posf = (float)*(const GAS int*)(posb + tq);
#pragma unroll
        for (int f = 0; f < 2; ++f) { const int d1 = 128 + 16 * f + hi * 8, d2 = d1 + 32;
            const f32x4 ga = *(LAS const f32x4*)(GL + d1), gb = *(LAS const f32x4*)(GL + d1 + 4), ha = *(LAS const f32x4*)(GL + d2), hb = *(LAS const f32x4*)(GL + d2 + 4);
            const f32x4 iva = *(LAS const f32x4*)(GL + 512 + 16 * f + 8 * hi), ivb = *(LAS const f32x4*)(GL + 512 + 16 * f + 8 * hi + 4);
            float o1[8], o2[8];
#pragma unroll
            for (int e = 0; e < 8; ++e) {
                const float t1 = bf2f(qr[8 + f][e]) * rstd * (e < 4 ? ga[e & 3] : gb[e & 3]);
                const float t2 = bf2f(qr[10 + f][e]) * rstd * (e < 4 ? ha[e & 3] : hb[e & 3]);
                const float inv = (e < 4 ? iva[e & 3] : ivb[e & 3]);
                const float ang = posf * inv;
                const float kq = rintf(ang * 0.15915494309189535f);
                float rr = fmaf(-kq, 6.28125f, ang); rr = fmaf(-kq, 1.9353071795864769e-3f, rr);
                const float sn = __sinf(rr), cs = __cosf(rr);
                o1[e] = t1 * cs - t2 * sn; o2[e] = t2 * cs + t1 * sn;
            }
            u32x4 w1, w2;
            w1.x = cvt_pk_bf16(o1[0], o1[1]); w1.y = cvt_pk_bf16(o1[2], o1[3]); w1.z = cvt_pk_bf16(o1[4], o1[5]); w1.w = cvt_pk_bf16(o1[6], o1[7]);
            w2.x = cvt_pk_bf16(o2[0], o2[1]); w2.y = cvt_pk_bf16(o2[2], o2[3]); w2.z = cvt_pk_bf16(o2[4], o2[5]); w2.w = cvt_pk_bf16(o2[6], o2[7]);
            qr[8 + f] = __builtin_bit_cast(bf16x8, w1); qr[10 + f] = __builtin_bit_cast(bf16x8, w2); }
    }
    f32x16 o[4]; f32x16 p0, p1;
#pragma unroll
    for (int d = 0; d < 4; ++d)
#pragma unroll
        for (int r = 0; r < 16; ++r) o[d][r] = 0.f;
#pragma unroll
    for (int r = 0; r < 16; ++r) { p0[r] = 0.f; p1[r] = 0.f; }
    SWRITE(0, 0); __syncthreads();

#define SBHALF(P, coff, carry_in, run_out) do { f32x16 lq; \
        _Pragma("unroll") for (int r = 0; r < 16; ++r) { const float z = P[r] * C2; const float e = __builtin_amdgcn_exp2f(-fabsf(z)); const float L = __builtin_amdgcn_logf(1.f + e); const float lb = fminf(z, 0.f) - L; P[r] = lb; lq[r] = lb - z; } \
        if (needmask) { const float NEG = -__builtin_inff(); \
            _Pragma("unroll") for (int r = 0; r < 16; ++r) { const int c = (r & 3) + 8 * (r >> 2) + (coff); if (dq - c <= 0) { P[r] = NEG; lq[r] = 0.f; } } } \
        float mn_[4], pr_[4], th_[4], bs_[4]; \
        _Pragma("unroll") for (int i = 0; i < 4; ++i) mn_[i] = (lq[4*i] + lq[4*i+1]) + (lq[4*i+2] + lq[4*i+3]); \
        _Pragma("unroll") for (int i = 0; i < 4; ++i) { auto rr = __builtin_amdgcn_permlane32_swap(__float_as_uint(mn_[i]), __float_as_uint(mn_[i]), false, false); \
            pr_[i] = __uint_as_float(rr[0]) + __uint_as_float(rr[1]); th_[i] = __uint_as_float(rr[1]) * m0; } \
        float run = (carry_in); \
        _Pragma("unroll") for (int i = 3; i >= 0; --i) { bs_[i] = run + th_[i]; run += pr_[i]; } \
        _Pragma("unroll") for (int i = 0; i < 4; ++i) { float s = bs_[i]; \
            const float w3 = __builtin_amdgcn_exp2f(P[4*i+3] + s); s += lq[4*i+3]; const float w2 = __builtin_amdgcn_exp2f(P[4*i+2] + s); s += lq[4*i+2]; \
            const float w1 = __builtin_amdgcn_exp2f(P[4*i+1] + s); s += lq[4*i+1]; const float w0 = __builtin_amdgcn_exp2f(P[4*i] + s); \
            P[4*i] = w0; P[4*i+1] = w1; P[4*i+2] = w2; P[4*i+3] = w3; } \
        run_out = run; } while (0)

#define SMPV(j_, v3_) do { const int kb_ = (j_) * 64; bf16x8 pa0, pa1, pa2, pa3; \
        const bool needmask = kb_ + 63 >= qlo; const int dq = tq - kb_ - 4 * hi; \
        if constexpr (MODE == 0) { \
            float r1_, r0_; \
            SBHALF(p1, 32, Rc, r1_); SBHALF(p0, 0, r1_, r0_); \
            Rc = r0_; wdone = __all(Rc < -160.f); \
        } else { \
            if constexpr (MODE == 1) { \
                _Pragma("unroll") for (int i = 0; i < 4; ++i) { const f32x4 fa = *(LAS const f32x4*)(F2L + kb_ + 8 * i + 4 * hi); const f32x4 fb = *(LAS const f32x4*)(F2L + kb_ + 32 + 8 * i + 4 * hi); \
                    const f32x4 ra = *(LAS const f32x4*)(RK + kb_ + 8 * i + 4 * hi); const f32x4 rb = *(LAS const f32x4*)(RK + kb_ + 32 + 8 * i + 4 * hi); \
                    _Pragma("unroll") for (int u = 0; u < 4; ++u) { p0[4*i+u] = fmaf(p0[4*i+u], ra[u], f2t - fa[u]); p1[4*i+u] = fmaf(p1[4*i+u], rb[u], f2t - fb[u]); } } \
            } else { \
                _Pragma("unroll") for (int i = 0; i < 4; ++i) { const f32x4 ra = *(LAS const f32x4*)(RK + kb_ + 8 * i + 4 * hi); const f32x4 rb = *(LAS const f32x4*)(RK + kb_ + 32 + 8 * i + 4 * hi); \
                    _Pragma("unroll") for (int u = 0; u < 4; ++u) { p0[4*i+u] *= ra[u]; p1[4*i+u] *= rb[u]; } } \
            } \
            if (needmask) { const float NEG = -__builtin_inff(); \
                _Pragma("unroll") for (int r = 0; r < 16; ++r) { const int c = (r & 3) + 8 * (r >> 2); if (dq - c < 0) p0[r] = NEG; if (dq - c - 32 < 0) p1[r] = NEG; } } \
            float pma = fmaxf(fmaxf(p0[0], p0[1]), p1[0]), pmb = fmaxf(fmaxf(p0[2], p0[3]), p1[1]); pma = fmaxf(fmaxf(pma, p1[2]), p1[3]); \
            _Pragma("unroll") for (int r = 4; r < 16; r += 4) { pma = fmaxf(fmaxf(pma, p0[r]), p0[r+1]); pmb = fmaxf(fmaxf(pmb, p0[r+2]), p0[r+3]); pma = fmaxf(fmaxf(pma, p1[r]), p1[r+1]); pmb = fmaxf(fmaxf(pmb, p1[r+2]), p1[r+3]); } \
            float pmax = swap_max(fmaxf(pma, pmb)); \
            const float SC = 1.f; \
            float mn, alpha; \
            if (__all(pmax - m_reg <= 11.5f)) { mn = m_reg; alpha = 1.f; } else { mn = fmaxf(m_reg, pmax); alpha = __builtin_amdgcn_exp2f(m_reg - mn); m_reg = mn; } \
            float psa = 0.f, psb = 0.f; const float nmn = -mn; \
            _Pragma("unroll") for (int r = 0; r < 16; ++r) { p0[r] = __builtin_amdgcn_exp2f(fmaf(p0[r], SC, nmn)); p1[r] = __builtin_amdgcn_exp2f(fmaf(p1[r], SC, nmn)); psa += p0[r]; psb += p1[r]; } \
            const float ps = swap_sum(psa + psb); l_reg = l_reg * alpha + ps; \
            if (__any(alpha < 1.f)) { if (hi == 0) al_l[r32] = alpha; asm volatile("s_waitcnt lgkmcnt(0)" ::: "memory"); \
                _Pragma("unroll") for (int r = 0; r < 16; ++r) { const float a_ = al_l[crow(r, hi)]; o[0][r] *= a_; o[1][r] *= a_; o[2][r] *= a_; o[3][r] *= a_; } \
                asm volatile("s_waitcnt lgkmcnt(0)" ::: "memory"); } \
        } \
        PK4(p0, 0, pa0); PK4(p0, 8, pa1); PK4(p1, 0, pa2); PK4(p1, 8, pa3); \
        SBAR(); pv_tile(o, vb0 + (v3_) * 16384, pa0, pa1, pa2, pa3); } while (0)

    int k2 = 0, v3 = 0;
    if (grpB) __builtin_amdgcn_s_setprio(1);
#pragma nounroll
    for (int t = 0; t <= NT; ++t) {
        const bool more = t < NT;
        const int j = JT(t), kb = j * 64;
        if (t + 1 < NT) SLOAD(JT(t + 1));
        const bool inrange = more && (kb <= qlo + 31);
        if (!grpB && inrange && !wdone) { qkt<MODE>(p0, p1, K_lds, P_lds, k2, r32, hi, qr); pend = true; pj = j; pv3 = v3; }
        if (pend) { SMPV(pj, pv3); pend = false; }
        if (grpB && inrange && !wdone) { qkt<MODE>(p0, p1, K_lds, P_lds, k2, r32, hi, qr); pend = true; pj = j; pv3 = v3; }
        const int k2n = k2 ^ 1, v3n = (v3 == 2) ? 0 : v3 + 1;
        if constexpr (MODE == 0) { if ((!wdone || pend) && lane == 0) flg[v3] = 1; }
        if (t + 1 < NT) { SWRITE(k2n, v3n); }
        __syncthreads();
        if constexpr (MODE == 0) { const int any_ = flg[v3]; if (tid == 0) flg[(v3n == 2) ? 0 : v3n + 1] = 0; if (!any_) stop = true; }
        k2 = k2n; v3 = v3n;
        if (stop) break;
    }

    __builtin_amdgcn_s_setprio(0);
    float rli[16];
    if constexpr (MODE == 0) {
#pragma unroll
        for (int r = 0; r < 16; ++r) rli[r] = 1.f;
    } else {
        if (hi == 0) li_l[r32] = l_reg; asm volatile("s_waitcnt lgkmcnt(0)" ::: "memory");
#pragma unroll
        for (int r = 0; r < 16; ++r) rli[r] = 1.0f / li_l[crow(r, hi)];
        asm volatile("s_waitcnt lgkmcnt(0)" ::: "memory");
    }
    bf16_t* Ow = Op + (size_t)qlo * ldo;
    LAS bf16_t* stg = (LAS bf16_t*)(lds + wid * 8192);
#pragma unroll
    for (int r = 0; r < 16; ++r) { const int orow = crow(r, hi);
#pragma unroll
        for (int d0 = 0; d0 < 4; ++d0) { const float v = o[d0][r] * rli[r]; stg[orow * 128 + d0 * 32 + r32] = (bf16_t)(cvt_pk_bf16(v, v) & 0xffffu); } }
    asm volatile("s_waitcnt lgkmcnt(0)" ::: "memory");
#pragma unroll
    for (int i = 0; i < 8; ++i) { const int row = i * 4 + (lane >> 4), ch = lane & 15;
        const u32x4 v = *(LAS const u32x4*)(stg + row * 128 + ch * 8);
        *(GAS u32x4*)(Ow + (size_t)row * ldo + ch * 8) = v; }
    __syncthreads();
#undef JT
#undef SLOAD
#undef SWRITE
#undef SMPV
#undef SBHALF
}


#define XB_TMO      128
#define XB_XCNT(j)  (256  + 64 * (j))
#define XB_XSUB(j)  (1280 + 64 * (j))
#define XB_XGEN(j)  (2304 + 64 * (j))
#define XB_TOP      3328
#define XB_TOPGEN   3392
#define XCD_BAR_WORDS 3456
#define XB_SPIN_CAP (1u << 18)

__device__ __forceinline__ unsigned xb_ld(unsigned* p)              { return __hip_atomic_load(p, __ATOMIC_RELAXED, __HIP_MEMORY_SCOPE_AGENT); }
__device__ __forceinline__ unsigned xb_add(unsigned* p, unsigned v) { return __hip_atomic_fetch_add(p, v, __ATOMIC_RELAXED, __HIP_MEMORY_SCOPE_AGENT); }
__device__ __forceinline__ unsigned xb_xcc_id() { return (unsigned)__builtin_amdgcn_s_getreg((3 << 11) | 20) & 0xFu; }
#define XB_SPIN(cond, bar) do { unsigned _sp = 0; while (cond) { __builtin_amdgcn_s_sleep(1); \
    if ((++_sp & 255u) == 0u) { if (xb_ld(&(bar)[XB_TMO])) break; if (_sp > XB_SPIN_CAP) { atomicAdd(&(bar)[XB_TMO], 1u); break; } } } } while (0)

struct XcdBarrier {
    unsigned* bar; unsigned x;
    volatile LAS unsigned* st;
};

__device__ __forceinline__ XcdBarrier xcd_barrier_post(unsigned* bar, volatile LAS unsigned* st) {
    XcdBarrier b; b.bar = bar; b.x = xb_xcc_id(); b.st = st;
    if (threadIdx.x == 0) (void)xb_add(&bar[XB_XCNT(b.x)], 1u);
    return b;
}
__device__ __forceinline__ void xcd_barrier_complete(unsigned* bar, unsigned x, unsigned& nloc, unsigned& nx) {
    const unsigned G = gridDim.x * gridDim.y * gridDim.z;
    unsigned sum, cnt, mine, sp = 0u;
    for (;;) {
        sum = 0u; cnt = 0u; mine = 0u;
#pragma unroll
        for (unsigned j = 0; j < 16; ++j) { const unsigned c = xb_ld(&bar[XB_XCNT(j)]); sum += c; cnt += (c > 0u) ? 1u : 0u; mine = (j == x) ? c : mine; }
        if (sum == G) break;
        __builtin_amdgcn_s_sleep(1);
        if ((++sp & 255u) == 0u) { if (xb_ld(&bar[XB_TMO])) break; if (sp > XB_SPIN_CAP) { atomicAdd(&bar[XB_TMO], 1u); break; } }
    }
    nloc = mine > 0u ? mine : 1u; nx = cnt > 0u ? cnt : 1u;
}

__device__ __forceinline__ void xcd_barrier(const XcdBarrier& b) {
    asm volatile("s_waitcnt vmcnt(0)" ::: "memory");
    __syncthreads();
    if (threadIdx.x == 0) {
        unsigned* bar = b.bar;
        __builtin_amdgcn_s_waitcnt(0);
        unsigned nloc = b.st[0], nx = b.st[1];
        if (nloc == 0u) { xcd_barrier_complete(bar, b.x, nloc, nx); b.st[0] = nloc; b.st[1] = nx; }
        const unsigned old = xb_add(&bar[XB_XSUB(b.x)], 1u);
        const unsigned gen = old / nloc;
        if (old + 1u == (gen + 1u) * nloc) {
            __builtin_amdgcn_fence(__ATOMIC_RELEASE, "agent");
            asm volatile("s_waitcnt vmcnt(0)" ::: "memory");
            const unsigned og = xb_add(&bar[XB_TOP], 1u);
            const unsigned tg = og / nx;
            if (og + 1u == (tg + 1u) * nx) xb_add(&bar[XB_TOPGEN], 1u);
            else XB_SPIN(xb_ld(&bar[XB_TOPGEN]) == tg, bar);
            __builtin_amdgcn_fence(__ATOMIC_ACQUIRE, "agent");
            xb_add(&bar[XB_XGEN(b.x)], 1u);
            asm volatile("s_waitcnt vmcnt(0)" ::: "memory");
        } else {
            XB_SPIN(xb_ld(&bar[XB_XGEN(b.x)]) == gen, bar);
            __builtin_amdgcn_fence(__ATOMIC_ACQUIRE, "agent");
            asm volatile("s_waitcnt vmcnt(0)" ::: "memory");
        }
    }
    __syncthreads();
}

struct Params {
    const float* x; const int* pos; const float* ln_mix_g; const float* ln_mlp_g; const float* w_in; const float* b_f; const float* fox_q_g; const float* fox_k_g; const float* w_o0;
    const float* mla_w_down; const float* q_a_g; const float* kv_a_g; const float* w_uq; const float* w_ukv; const float* mla_q_g; const float* mla_k_g; const float* w_o1;
    const float* w_up; const float* w_dn; float* out; unsigned char* ws;
};

__device__ __forceinline__ void transpose_block_item(const float* W, int K, int N, int ldw, const float* g, bf16_t* WT, LAS float* tile, int item, int tid) {
    const int nblk = (N + 255) / 256, kb = item / nblk, nb = item % nblk, k0 = 64 * kb, n0 = 256 * nb;
    const int rr = tid >> 6, c4 = (tid & 63) * 4;
    const bool colok = n0 + c4 < N;
    f32x4 tv[8];
#pragma unroll
    for (int i = 0; i < 8; ++i) tv[i] = colok ? *(const GAS f32x4*)(W + (size_t)(k0 + i * 8 + rr) * ldw + n0 + c4) : (f32x4){0.f, 0.f, 0.f, 0.f};
    if (g) {
#pragma unroll
        for (int i = 0; i < 8; ++i) tv[i] = tv[i] * *(const GAS float*)(g + k0 + i * 8 + rr);
    }
#pragma unroll
    for (int i = 0; i < 8; ++i) *(LAS f32x4*)(tile + (i * 8 + rr) * 260 + c4) = tv[i];
    __syncthreads();
    const int n = tid >> 1, kh = (tid & 1) * 32;
    if (n0 + n < N) {
        float f[32];
#pragma unroll
        for (int j = 0; j < 32; ++j) f[j] = tile[(kh + j) * 260 + n];
        bf16_t* dst = WT + (size_t)(n0 + n) * K + k0 + kh;
#pragma unroll
        for (int q = 0; q < 4; ++q) { u32x4 o; o.x = cvt_pk_bf16(f[8 * q], f[8 * q + 1]); o.y = cvt_pk_bf16(f[8 * q + 2], f[8 * q + 3]); o.z = cvt_pk_bf16(f[8 * q + 4], f[8 * q + 5]); o.w = cvt_pk_bf16(f[8 * q + 6], f[8 * q + 7]);
            *(GAS u32x4*)(dst + 8 * q) = o; }
    }
    __syncthreads();
}

__device__ __forceinline__ void transpose_item(const float* W, int K, int N, int ldw, const float* g, bf16_t* WT, LAS float* scr, int item, int lane) {
    const int nblk = N / 32, kb = item / nblk, nb = item % nblk, k0 = 64 * kb, n0 = 32 * nb;
    float tv[32];
    const float* wp = W + (size_t)(k0 + (lane >> 5)) * ldw + n0 + (lane & 31);
#pragma unroll
    for (int i = 0; i < 32; ++i) tv[i] = wp[(size_t)(2 * i) * ldw];
    if (g) {
#pragma unroll
        for (int i = 0; i < 32; ++i) tv[i] *= g[k0 + 2 * i + (lane >> 5)];
    }
#pragma unroll
    for (int i = 0; i < 32; ++i) scr[(2 * i + (lane >> 5)) * 33 + (lane & 31)] = tv[i];
    asm volatile("s_waitcnt lgkmcnt(0)" ::: "memory");
    const int c = lane & 7;
#pragma unroll
    for (int j = 0; j < 4; ++j) { const int n = (lane >> 3) + 8 * j; const LAS float* s = scr + (8 * c) * 33 + n;
        u32x4 o; o.x = cvt_pk_bf16(s[0 * 33], s[1 * 33]); o.y = cvt_pk_bf16(s[2 * 33], s[3 * 33]); o.z = cvt_pk_bf16(s[4 * 33], s[5 * 33]); o.w = cvt_pk_bf16(s[6 * 33], s[7 * 33]);
        *(u32x4*)(WT + (size_t)(n0 + n) * K + k0 + 8 * c) = o; }
    asm volatile("s_waitcnt lgkmcnt(0)" ::: "memory");
}

__global__ void __launch_bounds__(512) mega_fwd(Params p) {
    extern __shared__ __attribute__((aligned(16))) unsigned char lds_raw[];
    LAS unsigned char* lds = (LAS unsigned char*)lds_raw;
    cg::grid_group grid = cg::this_grid();
    const int G = gridDim.x, bx = blockIdx.x; const int vcu = (G % 8 == 0) ? (bx % 8) * (G / 8) + bx / 8 : bx;
    const int NGW = G * 8;
    volatile LAS unsigned* bst = (volatile LAS unsigned*)(lds + LDS_BYTES - 16);
    if (threadIdx.x < 4) bst[threadIdx.x] = 0u;
    __syncthreads();
    const XcdBarrier xbar = xcd_barrier_post((unsigned*)(p.ws + WS_BAR), bst);
    if (p.ws == nullptr) grid.sync();
#pragma nounroll
    for (int step = 0; step < 15; ++step) {
        if (step == 2 || step == 10) continue;
        for (int rep = 0; rep < 1 + ((DUP_MASK >> step) & 1); ++rep) {
        int tid_l = threadIdx.x; asm volatile("" : "+v"(tid_l));
        const int tid = tid_l, lane = tid & 63, wave = __builtin_amdgcn_readfirstlane(tid >> 6);
        const int gw = vcu * 8 + wave;
        unsigned char* ws = p.ws; asm volatile("" : "+s"(ws));
        float* RS = (float*)(ws + WS_RS); float* RS0 = RS, *RS1 = RS + M, *RS2 = RS + 2 * M, *RS3 = RS + 3 * M, *RSQ = RS + 4 * M, *RSKV = RS + 5 * M;
        float* LF = (float*)(ws + WS_LF); float* F2 = (float*)(ws + WS_F2); float* KPE = (float*)(ws + WS_KPE);
        bf16_t* XB = (bf16_t*)(ws + WS_XB);
        bf16_t* Q0 = (bf16_t*)(ws + WS_Q0); bf16_t* K0 = (bf16_t*)(ws + WS_K0); bf16_t* V0 = (bf16_t*)(ws + WS_V0); bf16_t* HB = (bf16_t*)(ws + WS_H);
        bf16_t* Q1 = (bf16_t*)(ws + WS_Q1); bf16_t* K1 = (bf16_t*)(ws + WS_K1); bf16_t* V1 = (bf16_t*)(ws + WS_V1);
        float* KSS0 = (float*)(ws + WS_KSS0); float* KSS1 = (float*)(ws + WS_KSS1); bf16_t* KPR = (bf16_t*)(ws + WS_KPR); float* SSPE = (float*)(ws + WS_SSPE);
        bf16_t* AO0 = (bf16_t*)(ws + WS_AO0); bf16_t* CQ = (bf16_t*)(ws + WS_CQ); bf16_t* CKV = (bf16_t*)(ws + WS_CKV); bf16_t* AO1 = (bf16_t*)(ws + WS_AO1);
        if (step == 0) {
            LAS float* scr = (LAS float*)(lds + wave * 8448);
            LAS float* wfg = (LAS float*)(lds + 67584);
            for (int idx = tid; idx < 16384; idx += 512) { const int k = idx >> 3, j = idx & 7; wfg[j * 2048 + k] = p.w_in[(size_t)k * INW + 6144 + j] * p.ln_mix_g[k]; }
            for (int i = bx * 512 + tid; i < 5 * M; i += G * 512) RS1[i] = 0.f;
            for (int i = bx * 512 + tid; i < 8 * M; i += G * 512) KSS0[i] = 0.f;
            for (int i = bx * 512 + tid; i < 16 * M; i += G * 512) KSS1[i] = 0.f;
            __syncthreads();
            constexpr int I_IN = 32 * 24, I_O = 32 * 8, I_UP = 32 * 32, I_DN = 128 * 8, I_MD = 32 * 5, I_UQ = 8 * 12, I_UKV = 8 * 16;
            constexpr int NITEMS = I_IN + 2 * I_O + 2 * I_UP + 2 * I_DN + I_MD + I_UQ + I_UKV;
            LAS float* tile = (LAS float*)lds;
            for (int it = vcu; it < NITEMS; it += G) {
                int r = it;
                if (r < I_IN) { transpose_block_item(p.w_in, 2048, 6144, INW, p.ln_mix_g, (bf16_t*)(ws + WS_WIN), tile, r, tid); continue; } r -= I_IN;
                if (r < I_O) { transpose_block_item(p.w_o0, 2048, 2048, 2048, nullptr, (bf16_t*)(ws + WS_WO0), tile, r, tid); continue; } r -= I_O;
                if (r < I_UP) { transpose_block_item(p.w_up, 2048, 8192, 8192, p.ln_mlp_g, (bf16_t*)(ws + WS_WUP0), tile, r, tid); continue; } r -= I_UP;
                if (r < I_DN) { transpose_block_item(p.w_dn, 8192, 2048, 2048, nullptr, (bf16_t*)(ws + WS_WDN0), tile, r, tid); continue; } r -= I_DN;
                if (r < I_MD) { transpose_block_item(p.mla_w_down, 2048, 1088, 1088, p.ln_mix_g + 2048, (bf16_t*)(ws + WS_WMD), tile, r, tid); continue; } r -= I_MD;
                if (r < I_UQ) { transpose_block_item(p.w_uq, 512, 3072, 3072, p.q_a_g, (bf16_t*)(ws + WS_WUQ), tile, r, tid); continue; } r -= I_UQ;
                if (r < I_UKV) { transpose_block_item(p.w_ukv, 512, 4096, 4096, p.kv_a_g, (bf16_t*)(ws + WS_WUKV), tile, r, tid); continue; } r -= I_UKV;
                if (r < I_O) { transpose_block_item(p.w_o1, 2048, 2048, 2048, nullptr, (bf16_t*)(ws + WS_WO1), tile, r, tid); continue; } r -= I_O;
                if (r < I_UP) { transpose_block_item(p.w_up + (size_t)2048 * 8192, 2048, 8192, 8192, p.ln_mlp_g + 2048, (bf16_t*)(ws + WS_WUP1), tile, r, tid); continue; } r -= I_UP;
                transpose_block_item(p.w_dn + (size_t)8192 * 2048, 8192, 2048, 2048, nullptr, (bf16_t*)(ws + WS_WDN1), tile, r, tid);
            }
            __syncthreads();
            for (int m = gw; m < M; m += NGW) {
                const f32x4* xr = (const f32x4*)(p.x + (size_t)m * DM) + lane;
                f32x4 v[8]; float ss = 0.f;
#pragma unroll
                for (int c = 0; c < 8; ++c) { v[c] = xr[64 * c]; ss += (v[c][0] * v[c][0] + v[c][1] * v[c][1]) + (v[c][2] * v[c][2] + v[c][3] * v[c][3]); }
                float d[8];
#pragma unroll
                for (int j = 0; j < 8; ++j) { float a = 0.f;
#pragma unroll
                    for (int c = 0; c < 8; ++c) { const f32x4 w = *(LAS const f32x4*)(wfg + j * 2048 + c * 256 + lane * 4); a += (v[c][0] * w[0] + v[c][1] * w[1]) + (v[c][2] * w[2] + v[c][3] * w[3]); }
                    d[j] = wave_sum(a); }
                ss = wave_sum(ss);
                const float rstd = 1.0f / sqrtf(ss * (1.0f / DM) + EPS);
                if (lane == 0) RS0[m] = ss;
                if (lane < 8) { float dj = d[0];
#pragma unroll
                    for (int j = 1; j < 8; ++j) dj = (lane == j) ? d[j] : dj;
                    const float lg = dj * rstd + p.b_f[lane]; const float ls = fminf(lg, 0.f) - log1pf(expf(-fabsf(lg)));
                    LF[((size_t)(m / SEQ) * 8 + lane) * SEQ + (m % SEQ)] = ls * LOG2E; }
#pragma unroll
                for (int c = 0; c < 8; ++c) { u32x2 w; w.x = cvt_pk_bf16(v[c][0], v[c][1]); w.y = cvt_pk_bf16(v[c][2], v[c][3]); *(u32x2*)(XB + (size_t)m * DM + c * 256 + lane * 4) = w; }
            }
        } else if (step == 3) {
            const float C2 = 0.08838834764831845f * LOG2E;
            { LAS float* GLw = (LAS float*)(lds + A_GL); if (tid < 128) GLw[tid] = p.fox_q_g[tid] * p.fox_k_g[tid]; __syncthreads(); }
            for (int L = vcu; L < 512; L += G) {
                const int i = L >> 8, c = L & 255, b = c >> 6, h8 = (c >> 3) & 7, pp = c & 7, hh = i * 8 + h8;
                const size_t hoff = (size_t)b * SEQ * DM + hh * 128;
                for (int pass = 0; pass < 2; ++pass) {
                    const int qb = pass ? pp : 15 - pp;
#ifndef NO_SB
                    if (i == 0) attn_unit<0>((LAS char*)lds, Q0 + hoff, DM, K0 + hoff, DM, V0 + hoff, DM, AO0 + hoff, DM, nullptr, qb, C2, nullptr, nullptr, nullptr, 0, nullptr, nullptr, nullptr, true);
#endif
#ifndef NO_FOX
                    if (i != 0) attn_unit<1>((LAS char*)lds, Q0 + hoff, DM, K0 + hoff, DM, V0 + hoff, DM, AO0 + hoff, DM, F2 + (size_t)(b * 8 + h8) * SEQ, qb, C2,
                                             p.fox_q_g, p.fox_k_g, KSS0 + (size_t)b * SEQ * 8 + h8, 8, nullptr, nullptr, nullptr, pass == 0);
#endif
                }
            }
        } else if (step == 11) {
            const float C2 = 0.07216878364870322f * LOG2E;
            { LAS float* GLw = (LAS float*)(lds + A_GL); if (tid < 192) GLw[tid] = p.mla_q_g[tid] * (tid < 128 ? p.mla_k_g[tid] : 1.0f);
              if (tid < 32) GLw[512 + tid] = exp2f(-(float)tid * (13.287712379549449f / 32.0f)); __syncthreads(); }
            for (int L = vcu; L < 512; L += G) {
                const int i = L >> 8, c = L & 255, b = c >> 6, h8 = (c >> 3) & 7, pp = c & 7, hh = i * 8 + h8;
                const size_t qoff = (size_t)b * SEQ * 3072 + hh * 192, voff = (size_t)b * SEQ * 2048 + hh * 128, rb = (size_t)b * SEQ;
                for (int pass = 0; pass < 2; ++pass) {
                    const int qb = pass ? pp : 15 - pp;
#ifndef NO_MLA
                    attn_unit<2>((LAS char*)lds, Q1 + qoff, 3072, K1 + voff, 2048, V1 + voff, 2048, AO1 + voff, 2048, nullptr, qb, C2,
                                 p.mla_q_g, p.mla_k_g, KSS1 + rb * 16 + hh, 16, SSPE + rb, p.pos + rb, KPR + rb * 64, pass == 0);
#endif
                }
            }
        } else {
            if (step == 1) {
                if (bx < 32) {
                    const float* src = LF + (size_t)bx * SEQ; float* dst = F2 + (size_t)bx * SEQ;
                    const f32x4 a = *(const f32x4*)(src + tid * 8), b = *(const f32x4*)(src + tid * 8 + 4);
                    float v[8] = {a[0], a[1], a[2], a[3], b[0], b[1], b[2], b[3]};
#pragma unroll
                    for (int e = 1; e < 8; ++e) v[e] += v[e - 1];
                    const float total = v[7]; float incl = total;
#pragma unroll
                    for (int o = 1; o < 64; o <<= 1) { const float t = __shfl_up(incl, o); if (lane >= o) incl += t; }
                    LAS float* wt = (LAS float*)lds;
                    if (lane == 63) wt[wave] = incl;
                    __syncthreads();
                    float base = incl - total;
                    for (int w = 0; w < wave; ++w) base += wt[w];
                    f32x4 oa = {v[0] + base, v[1] + base, v[2] + base, v[3] + base}, ob = {v[4] + base, v[5] + base, v[6] + base, v[7] + base};
                    *(f32x4*)(dst + tid * 8) = oa; *(f32x4*)(dst + tid * 8 + 4) = ob;
                }
                __syncthreads();
            }
            if (step == 8) {
                for (int idx = bx * 512 + tid; idx < M * 32; idx += G * 512) {
                    const int m = idx >> 5, i = idx & 31;
                    const float a = KPE[(size_t)m * 64 + i], b = KPE[(size_t)m * 64 + 32 + i];
                    float ss = a * a + b * b;
                    ss += __shfl_xor(ss, 16); ss += __shfl_xor(ss, 8); ss += __shfl_xor(ss, 4); ss += __shfl_xor(ss, 2); ss += __shfl_xor(ss, 1);
                    if (i == 0) SSPE[m] = ss;
                    const float ta = a * p.mla_k_g[128 + i], tb = b * p.mla_k_g[160 + i];
                    const float inv = exp2f(-(float)i * (13.287712379549449f / 32.0f));
                    const float ang = (float)p.pos[m] * inv;
                    const float kq = rintf(ang * 0.15915494309189535f);
                    float rr = fmaf(-kq, 6.28125f, ang); rr = fmaf(-kq, 1.9353071795864769e-3f, rr);
                    const float sn = __sinf(rr), cs = __cosf(rr);
                    const float o1 = ta * cs - tb * sn, o2 = tb * cs + ta * sn;
                    KPR[(size_t)m * 64 + i] = (bf16_t)(cvt_pk_bf16(o1, o1) & 0xffffu);
                    KPR[(size_t)m * 64 + 32 + i] = (bf16_t)(cvt_pk_bf16(o2, o2) & 0xffffu);
                }
            }
            pg8::Gemm g; pg8::Epi E;
            E.kind = pg8::K_PLAIN; E.last = 0; E.d0 = nullptr; E.d1 = nullptr; E.d2 = nullptr; E.ldc = 0; E.rs = RS0; E.invn = 1.0f / DM;
            E.xold = nullptr; E.xout = nullptr; E.xb = XB; E.rsn = nullptr; E.kpe = KPE; E.rsq = RSQ; E.rskv = RSKV; E.kss = (step == 1) ? KSS0 : KSS1;
            g.M = M; g.A = XB; g.Bt = nullptr; g.N = 0; g.K = DM;
            switch (step) {
                case 1:  g.A = XB; g.Bt = (const bf16_t*)(ws + WS_WIN); g.N = 6144; g.K = 2048; E.kind = pg8::K_IN; E.d0 = Q0; E.d1 = K0; E.d2 = V0; E.rs = RS0; break;
                case 4:  g.A = AO0; g.Bt = (const bf16_t*)(ws + WS_WO0); g.N = 2048; g.K = 2048; E.kind = pg8::K_RES; E.xold = p.x; E.xout = p.out; E.rsn = RS1; break;
                case 5:  g.A = XB; g.Bt = (const bf16_t*)(ws + WS_WUP0); g.N = 8192; g.K = 2048; E.kind = pg8::K_UP; E.d0 = HB; E.ldc = DFF; E.rs = RS1; break;
                case 6:  g.A = HB; g.Bt = (const bf16_t*)(ws + WS_WDN0); g.N = 2048; g.K = 8192; E.kind = pg8::K_RES; E.xold = p.out; E.xout = p.out; E.rsn = RS2; break;
                case 7:  g.A = XB; g.Bt = (const bf16_t*)(ws + WS_WMD); g.N = 1280; g.K = 2048; E.kind = pg8::K_MDOWN; E.d0 = CQ; E.d1 = CKV; E.rs = RS2; break;
                case 8:  g.A = CQ; g.Bt = (const bf16_t*)(ws + WS_WUQ); g.N = 3072; g.K = 512; E.kind = pg8::K_PLAIN; E.d0 = Q1; E.ldc = 3072; E.rs = RSQ; E.invn = 1.0f / 512.f; break;
                case 9:  g.A = CKV; g.Bt = (const bf16_t*)(ws + WS_WUKV); g.N = 4096; g.K = 512; E.kind = pg8::K_UKV; E.d0 = K1; E.d1 = V1; E.rs = RSKV; E.invn = 1.0f / 512.f; break;
                case 12: g.A = AO1; g.Bt = (const bf16_t*)(ws + WS_WO1); g.N = 2048; g.K = 2048; E.kind = pg8::K_RES; E.xold = p.out; E.xout = p.out; E.rsn = RS3; break;
                case 13: g.A = XB; g.Bt = (const bf16_t*)(ws + WS_WUP1); g.N = 8192; g.K = 2048; E.kind = pg8::K_UP; E.d0 = HB; E.ldc = DFF; E.rs = RS3; break;
                default: g.A = HB; g.Bt = (const bf16_t*)(ws + WS_WDN1); g.N = 2048; g.K = 8192; E.kind = pg8::K_RES; E.xold = p.out; E.xout = p.out; E.rsn = RS3; E.last = 1; break;
            }
            pg8::StaticOrder S; S.init(M, g.N, G, bx);
#ifndef NO_GEMM
            pg8::gemm_phase<pg8::Epi, pg8::StaticOrder>(lds, g, S, E);
#endif
        }
        }
        if (step != 8 && step != 14) xcd_barrier(xbar);
    }
}

extern "C" void kernel_launch(void* const* d_in, const int* in_sizes, int n_in, void* d_out, int out_size, void* d_ws, size_t ws_size, hipStream_t stream) {
    static int grid_blocks = 0;
    if (grid_blocks == 0) {
        if (n_in != 19 || ws_size < WS_END || out_size != M * DM) { fprintf(stderr, "kernel_launch: unexpected shapes (n_in %d, ws %zu, out %d)\n", n_in, ws_size, out_size); grid_blocks = -1; return; }
        int dev = 0, cus = 0, per_cu = 0;
        (void)hipGetDevice(&dev);
        (void)hipDeviceGetAttribute(&cus, hipDeviceAttributeMultiprocessorCount, dev);
        (void)hipFuncSetAttribute((const void*)mega_fwd, hipFuncAttributeMaxDynamicSharedMemorySize, LDS_BYTES);
        if (hipOccupancyMaxActiveBlocksPerMultiprocessor(&per_cu, (const void*)mega_fwd, 512, LDS_BYTES) != hipSuccess || per_cu < 1) per_cu = 1;
        (void)hipGetLastError();
        grid_blocks = cus * per_cu;
    }
    if (grid_blocks < 0) return;
    Params p{};
    p.x = (const float*)d_in[0]; p.pos = (const int*)d_in[1]; p.ln_mix_g = (const float*)d_in[2]; p.ln_mlp_g = (const float*)d_in[3]; p.w_in = (const float*)d_in[4];
    p.b_f = (const float*)d_in[5]; p.fox_q_g = (const float*)d_in[6]; p.fox_k_g = (const float*)d_in[7]; p.w_o0 = (const float*)d_in[8]; p.mla_w_down = (const float*)d_in[9];
    p.q_a_g = (const float*)d_in[10]; p.kv_a_g = (const float*)d_in[11]; p.w_uq = (const float*)d_in[12]; p.w_ukv = (const float*)d_in[13]; p.mla_q_g = (const float*)d_in[14];
    p.mla_k_g = (const float*)d_in[15]; p.w_o1 = (const float*)d_in[16]; p.w_up = (const float*)d_in[17]; p.w_dn = (const float*)d_in[18];
    p.out = (float*)d_out; p.ws = (unsigned char*)d_ws;
    (void)hipMemsetAsync((unsigned char*)d_ws + WS_BAR, 0, 16384, stream);
    void* args[] = {&p};
    hipError_t e = hipLaunchCooperativeKernel((const void*)mega_fwd, dim3(grid_blocks), dim3(512), args, LDS_BYTES, stream);
    if (e != hipSuccess) fprintf(stderr, "cooperative launch failed: %s (grid %d)\n", hipGetErrorString(e), grid_blocks);
}
```

```cpp
#include <hip/hip_runtime.h>
#include <hip/hip_cooperative_groups.h>
#include <cstdio>
#include <cstdint>
namespace cg = cooperative_groups;

#define LAS __attribute__((address_space(3)))
#define GAS __attribute__((address_space(1)))
typedef unsigned short bf16_t;
typedef short bf16x8 __attribute__((ext_vector_type(8)));
typedef short s16x4 __attribute__((ext_vector_type(4)));
typedef float f32x4 __attribute__((ext_vector_type(4)));
typedef float f32x16 __attribute__((ext_vector_type(16)));
typedef unsigned u32x4 __attribute__((ext_vector_type(4)));
typedef unsigned u32x2 __attribute__((ext_vector_type(2)));

constexpr int NB = 4, SEQ = 4096, M = NB * SEQ, DM = 2048, DFF = 8192, INW = 6152;
constexpr float EPS = 1e-6f;
constexpr float LOG2E = 1.4426950408889634f;
constexpr size_t MiB = 1u << 20;
constexpr size_t WS_RS = 0;
constexpr size_t WS_LF = 512 * 1024, WS_F2 = 1 * MiB, WS_KPE = 2 * MiB, WS_BAR = 6 * MiB, WS_KSS0 = 6 * MiB + 512 * 1024, WS_KSS1 = 7 * MiB;
constexpr size_t WS_WIN = 8 * MiB, WS_WO0 = 32 * MiB, WS_WUP0 = 40 * MiB, WS_WDN0 = 72 * MiB;
constexpr size_t WS_CQ = 8 * MiB, WS_CKV = 24 * MiB, WS_AO1 = 40 * MiB;
constexpr size_t WS_WMD = 104 * MiB, WS_WUQ = 109 * MiB, WS_WUKV = 112 * MiB, WS_WO1 = 116 * MiB, WS_WUP1 = 124 * MiB, WS_WDN1 = 156 * MiB;
constexpr size_t WS_XB = 188 * MiB;
constexpr size_t WS_BIG = 252 * MiB;
constexpr size_t WS_Q0 = WS_BIG, WS_K0 = WS_BIG + 64 * MiB, WS_V0 = WS_BIG + 128 * MiB, WS_AO0 = WS_BIG + 192 * MiB, WS_H = WS_BIG;
constexpr size_t WS_Q1 = WS_BIG, WS_K1 = WS_BIG + 96 * MiB, WS_V1 = WS_BIG + 160 * MiB;
constexpr size_t WS_KPR = 508 * MiB, WS_SSPE = 510 * MiB;
constexpr size_t WS_END = 511 * MiB;
constexpr int LDS_BYTES = 147456;
#ifndef DUP_MASK
#define DUP_MASK 0
#endif

__device__ __forceinline__ unsigned cvt_pk_bf16(float lo, float hi) { unsigned r; asm volatile("v_cvt_pk_bf16_f32 %0, %1, %2" : "=v"(r) : "v"(lo), "v"(hi)); return r; }
__device__ __forceinline__ float bf2f(short s) { return __uint_as_float(((unsigned)(unsigned short)s) << 16); }
__device__ __forceinline__ float wave_sum(float v) {
#pragma unroll
    for (int o = 1; o < 64; o <<= 1) v += __shfl_xor(v, o);
    return v;
}

namespace pg8 {
constexpr int BM = 256, BK = 64, HALF = 128, HTB = HALF * BK * 2, STAGE_BYTES = 8 * HTB, NXCD = 8, WGM = 4;
__host__ __device__ __forceinline__ int lds_byte(int r, int c) { const int st = (r >> 4) * 2 + (c >> 5), rr = r & 15, cc = c & 31, ob = rr * 64 + cc * 2; return st * 1024 + (ob ^ (((ob >> 9) & 1) << 5)); }
__host__ __device__ __forceinline__ void stage_rc(int b, int& R, int& C) { const int st = b / 1024, sb = b % 1024, swz = sb ^ (((sb >> 9) & 1) << 5); R = (st >> 1) * 16 + swz / 64; C = (st & 1) * 32 + (swz % 64) / 2; }
__host__ __device__ __forceinline__ int perm32(int rho) { const int n = rho >> 4, i = rho & 15; return 8 * (i >> 2) + 4 * n + (i & 3); }
struct Unit { int pm, pn; };
struct Gemm { const bf16_t* A; const bf16_t* Bt; int M, N, K; };
struct StaticOrder {
    int nM, nN, nwg, G, c;
    __host__ __device__ void init(int M_, int N_, int G_, int c_) { nM = M_ / BM; nN = N_ / BM; nwg = nM * nN; G = G_; c = c_; }
    __host__ __device__ bool next(int i, Unit& u) const {
        const long L = (long)i * G + c; if (L >= nwg) return false;
        int wgid = (int)L; { const int q = nwg / NXCD, r = nwg % NXCD, xcd = wgid % NXCD, off = wgid / NXCD; wgid = (xcd < r ? xcd * (q + 1) : r * (q + 1) + (xcd - r) * q) + off; }
        const int nig = WGM * nN, gid = wgid / nig, fm = gid * WGM, gsz = (nM - fm) < WGM ? (nM - fm) : WGM;
        u.pm = fm + ((wgid % nig) % gsz); u.pn = (wgid % nig) / gsz; return true;
    }
};

enum { K_IN = 0, K_PLAIN = 1, K_UP = 2, K_UKV = 3, K_RES = 4, K_MDOWN = 5 };
struct Epi {
    static constexpr bool PERM = true;
    int kind; int last;
    bf16_t* d0; bf16_t* d1; bf16_t* d2; int ldc;
    const float* rs; float invn;
    const float* xold; float* xout; bf16_t* xb; float* rsn;
    float* kpe; float* rsq; float* rskv; float* kss;
    __device__ __forceinline__ void operator()(const f32x4 (&acc)[2][2][4][2], const Unit& u, int wr, int wc, int fr, int fq) const {
        const int row0 = u.pm * BM + wr * 64 + fr; const int lc = wc * 32 + 8 * fq;
        if (kind == K_RES) {
#pragma unroll
            for (int ai = 0; ai < 2; ++ai) {
                u32x4 xo[4][2];
#pragma unroll
                for (int m = 0; m < 4; ++m)
#pragma unroll
                    for (int bj = 0; bj < 2; ++bj)
                        xo[m][bj] = *(const GAS u32x4*)(xb + (size_t)(row0 + ai * HALF + m * 16) * DM + u.pn * BM + bj * HALF + lc);
                asm volatile("" ::: "memory");
#pragma unroll
                for (int m = 0; m < 4; ++m) {
                    const int row = row0 + ai * HALF + m * 16; float ss = 0.f;
#pragma unroll
                    for (int bj = 0; bj < 2; ++bj) {
                        const size_t off = (size_t)row * DM + u.pn * BM + bj * HALF + lc; const u32x4 x = xo[m][bj];
                        f32x4 a = {__uint_as_float(x.x << 16), __uint_as_float(x.x & 0xffff0000u), __uint_as_float(x.y << 16), __uint_as_float(x.y & 0xffff0000u)};
                        f32x4 b = {__uint_as_float(x.z << 16), __uint_as_float(x.z & 0xffff0000u), __uint_as_float(x.w << 16), __uint_as_float(x.w & 0xffff0000u)};
                        a += acc[ai][bj][m][0]; b += acc[ai][bj][m][1];
                        if (!last) {
                            ss += (a[0] * a[0] + a[1] * a[1]) + (a[2] * a[2] + a[3] * a[3]) + (b[0] * b[0] + b[1] * b[1]) + (b[2] * b[2] + b[3] * b[3]);
                            u32x4 w; w.x = cvt_pk_bf16(a[0], a[1]); w.y = cvt_pk_bf16(a[2], a[3]); w.z = cvt_pk_bf16(b[0], b[1]); w.w = cvt_pk_bf16(b[2], b[3]);
                            *(GAS u32x4*)(xb + off) = w;
                        } else { *(GAS f32x4*)(xout + off) = a; *(GAS f32x4*)(xout + off + 4) = b; }
                    }
                    if (!last) { ss += __shfl_xor(ss, 16); ss += __shfl_xor(ss, 32); if (fq == 0) __hip_atomic_fetch_add((GAS float*)(rsn + row), ss, __ATOMIC_RELAXED, __HIP_MEMORY_SCOPE_AGENT); }
                }
                asm volatile("" ::: "memory");
            }
            return;
        }
        if (kind == K_MDOWN && u.pn == 4) {
            if (wc < 2) {
                float rsk[8];
#pragma unroll
                for (int i = 0; i < 8; ++i) rsk[i] = *(const GAS float*)(rs + row0 + (i >> 2) * HALF + (i & 3) * 16);
#pragma unroll
                for (int ai = 0; ai < 2; ++ai)
#pragma unroll
                    for (int m = 0; m < 4; ++m) {
                        const int row = row0 + ai * HALF + m * 16; const float sc = 1.0f / sqrtf(rsk[ai * 4 + m] * invn + EPS);
                        float* o = kpe + (size_t)row * 64 + lc;
                        *(GAS f32x4*)o = acc[ai][0][m][0] * sc; *(GAS f32x4*)(o + 4) = acc[ai][0][m][1] * sc;
                    }
            }
            return;
        }
        bf16_t* p0; bf16_t* p1; int ld0, ld1; float* ssd = nullptr; float* hs0 = nullptr; float* hs1 = nullptr; int hld = 0;
        if (kind == K_IN) { const int grp = u.pn >> 2, buf = grp % 3; bf16_t* base = d0 + (size_t)buf * (32u << 20);
            p0 = base + (grp / 3) * 1024 + (u.pn & 3) * 256 + lc; p1 = p0 + HALF; ld0 = ld1 = DM;
            if (grp == 4) { hs0 = kss + 2 * (u.pn & 3); hs1 = hs0 + 1; hld = 8; } }
        else if (kind == K_UKV) { p0 = d0 + u.pn * 128 + lc; ld0 = 2048; p1 = d1 + u.pn * 128 + lc; ld1 = 2048; hs0 = kss + u.pn; hld = 16; }
        else if (kind == K_MDOWN) { bf16_t* base = d0 + (size_t)(u.pn >> 1) * (8u << 20); p0 = base + (u.pn & 1) * 256 + lc; p1 = p0 + HALF; ld0 = ld1 = 512; ssd = rsq + (size_t)(u.pn >> 1) * M; }
        else { p0 = d0 + u.pn * BM + lc; p1 = p0 + HALF; ld0 = ld1 = ldc; }
        const bool act = (kind == K_UP);
        float rsv[8];
#pragma unroll
        for (int i = 0; i < 8; ++i) rsv[i] = *(const GAS float*)(rs + row0 + (i >> 2) * HALF + (i & 3) * 16);
#pragma unroll
        for (int ai = 0; ai < 2; ++ai)
#pragma unroll
            for (int m = 0; m < 4; ++m) {
                const int row = row0 + ai * HALF + m * 16; const float sc = 1.0f / sqrtf(rsv[ai * 4 + m] * invn + EPS); float ssb[2];
#pragma unroll
                for (int bj = 0; bj < 2; ++bj) {
                    f32x4 a = acc[ai][bj][m][0] * sc, b = acc[ai][bj][m][1] * sc;
                    if (act) {
#pragma unroll
                        for (int e = 0; e < 4; ++e) { const float x = fmaxf(a[e], 0.f), y = fmaxf(b[e], 0.f); a[e] = x * x; b[e] = y * y; }
                    }
                    ssb[bj] = (a[0] * a[0] + a[1] * a[1]) + (a[2] * a[2] + a[3] * a[3]) + (b[0] * b[0] + b[1] * b[1]) + (b[2] * b[2] + b[3] * b[3]);
                    u32x4 w; w.x = cvt_pk_bf16(a[0], a[1]); w.y = cvt_pk_bf16(a[2], a[3]); w.z = cvt_pk_bf16(b[0], b[1]); w.w = cvt_pk_bf16(b[2], b[3]);
                    bf16_t* dst = bj == 0 ? p0 + (size_t)row * ld0 : p1 + (size_t)row * ld1;
                    *(GAS u32x4*)dst = w;
                }
                if (hs0) { float t0 = ssb[0]; t0 += __shfl_xor(t0, 16); t0 += __shfl_xor(t0, 32); if (fq == 0) __hip_atomic_fetch_add((GAS float*)(hs0 + (size_t)row * hld), t0, __ATOMIC_RELAXED, __HIP_MEMORY_SCOPE_AGENT); }
                if (hs1) { float t1 = ssb[1]; t1 += __shfl_xor(t1, 16); t1 += __shfl_xor(t1, 32); if (fq == 0) __hip_atomic_fetch_add((GAS float*)(hs1 + (size_t)row * hld), t1, __ATOMIC_RELAXED, __HIP_MEMORY_SCOPE_AGENT); }
                const float ss = ssb[0] + ssb[1];
                if (ssd) { float t2 = ss; t2 += __shfl_xor(t2, 16); t2 += __shfl_xor(t2, 32); if (fq == 0) __hip_atomic_fetch_add((GAS float*)(ssd + row), t2, __ATOMIC_RELAXED, __HIP_MEMORY_SCOPE_AGENT); }
            }
    }
};

template <class EpiT, class Sched>
__device__ __forceinline__ void gemm_phase(LAS unsigned char* lds, const Gemm g, const Sched& S, const EpiT& E) {
    int tid_l = threadIdx.x; asm volatile("" : "+v"(tid_l));
    const int tid = tid_l, wid = __builtin_amdgcn_readfirstlane(tid >> 6), lane = tid & 63, wr = wid >> 2, wc = wid & 3, fr = lane & 15, fq = lane >> 4;
    const int K = g.K, nt = K / BK;
    unsigned voffA[2], voffB[2];
#pragma unroll
    for (int i = 0; i < 2; ++i) { int R, C; stage_rc(tid * 16 + i * 8192, R, C); const int Rb = EpiT::PERM ? ((R & ~31) + perm32(R & 31)) : R;
        voffA[i] = (unsigned)(R * K + C) * 2u; voffB[i] = (unsigned)(Rb * K + C) * 2u; }
    const size_t kstep = (size_t)(BK * 2);
    const size_t hstep = (size_t)HALF * K * 2;
    const size_t tstep = 2 * hstep;
    const unsigned ldsw = (unsigned)wid * 1024u;
    const int aoff = lds_byte(wr * 64 + fr, fq * 8), boff = lds_byte(wc * 32 + fr, fq * 8);
#define PG8_SA(b, h) (((b) * 2 + (h)) * HTB)
#define PG8_SB(b, h) ((4 + (b) * 2 + (h)) * HTB)
#define PG8_STAGE(bufoff, gbase, voff) do { _Pragma("unroll") for (int _i = 0; _i < 2; ++_i) \
        __builtin_amdgcn_global_load_lds((const unsigned*)((const char*)(gbase) + (voff)[_i]), (LAS unsigned*)(lds + (bufoff) + ldsw + _i * 8192), 16, 0, 0); } while (0)
#define PG8_LDA(dst, b, h) do { _Pragma("unroll") for (int m = 0; m < 4; ++m) _Pragma("unroll") for (int k = 0; k < 2; ++k) dst[m][k] = *(const LAS bf16x8*)(lds + PG8_SA(b, h) + aoff + m * 2048 + k * 1024); } while (0)
#define PG8_LDB(dst, b, h) do { _Pragma("unroll") for (int n = 0; n < 2; ++n) _Pragma("unroll") for (int k = 0; k < 2; ++k) dst[n][k] = *(const LAS bf16x8*)(lds + PG8_SB(b, h) + boff + n * 2048 + k * 1024); } while (0)
#define PG8_MMA(ai, bj, At, Bt) do { __builtin_amdgcn_s_setprio(1); _Pragma("unroll") for (int m = 0; m < 4; ++m) _Pragma("unroll") for (int n = 0; n < 2; ++n) _Pragma("unroll") for (int k = 0; k < 2; ++k) \
        acc[ai][bj][m][n] = __builtin_amdgcn_mfma_f32_16x16x32_bf16(Bt[n][k], At[m][k], acc[ai][bj][m][n], 0, 0, 0); __builtin_amdgcn_s_setprio(0); } while (0)
#define PG8_WAIT_V(n) asm volatile("s_waitcnt vmcnt(" #n ")" ::: "memory")
#define PG8_WAIT_L(n) asm volatile("s_waitcnt lgkmcnt(" #n ")" ::: "memory")
#define PG8_BAR __builtin_amdgcn_s_barrier()
#define PG8_SCHED __builtin_amdgcn_sched_barrier(0)
    Unit cur, nxt; int ui = 0;
    if (!S.next(0, cur)) return;
    f32x4 acc[2][2][4][2];
#pragma unroll
    for (int a = 0; a < 2; ++a)
#pragma unroll
        for (int b = 0; b < 2; ++b)
#pragma unroll
            for (int m = 0; m < 4; ++m)
#pragma unroll
                for (int n = 0; n < 2; ++n) acc[a][b][m][n] = (f32x4){0.f, 0.f, 0.f, 0.f};
    bf16x8 At[4][2], B0[2][2], B1[2][2];
    const char* cA = (const char*)g.A + (size_t)cur.pm * tstep; const char* cB = (const char*)g.Bt + (size_t)cur.pn * tstep;
    {
        PG8_STAGE(PG8_SB(0, 0), cB, voffB); PG8_STAGE(PG8_SB(0, 1), cB + hstep, voffB); PG8_STAGE(PG8_SA(0, 0), cA, voffA); PG8_STAGE(PG8_SA(0, 1), cA + hstep, voffA);
        if (wr == 1) PG8_BAR;
        PG8_WAIT_V(2); PG8_BAR;
        PG8_STAGE(PG8_SB(1, 0), cB + kstep, voffB); PG8_STAGE(PG8_SA(1, 0), cA + kstep, voffA); PG8_STAGE(PG8_SB(1, 1), cB + hstep + kstep, voffB);
        PG8_WAIT_V(6); PG8_BAR;
    }
    for (;;) {
        const bool has_next = S.next(ui + 1, nxt);
        const char* nA = has_next ? (const char*)g.A + (size_t)nxt.pm * tstep : cA; const char* nB = has_next ? (const char*)g.Bt + (size_t)nxt.pn * tstep : cB;
        for (int t = 0; t < nt; t += 2) {
            const bool last = (t == nt - 2);
            const char* a1 = cA + (size_t)(t + 1) * kstep;
            const char* a2 = last ? nA : cA + (size_t)(t + 2) * kstep; const char* b2 = last ? nB : cB + (size_t)(t + 2) * kstep;
            const char* a3 = a2 + kstep; const char* b3 = b2 + kstep;
            PG8_LDB(B0, 0, 0); PG8_LDB(B1, 0, 1); PG8_SCHED; PG8_LDA(At, 0, 0); PG8_STAGE(PG8_SA(1, 1), a1 + hstep, voffA);
            PG8_WAIT_V(8); PG8_WAIT_L(0); PG8_BAR; PG8_MMA(0, 0, At, B0); PG8_MMA(0, 1, At, B1); PG8_BAR; PG8_SCHED;
            PG8_LDA(At, 0, 1); PG8_STAGE(PG8_SB(0, 0), b2, voffB); PG8_STAGE(PG8_SB(0, 1), b2 + hstep, voffB); PG8_STAGE(PG8_SA(0, 0), a2, voffA);
            PG8_WAIT_V(8); PG8_WAIT_L(0); PG8_BAR; PG8_MMA(1, 0, At, B0); PG8_MMA(1, 1, At, B1); PG8_BAR; PG8_SCHED;
            PG8_LDB(B0, 1, 0); PG8_LDB(B1, 1, 1); PG8_SCHED; PG8_LDA(At, 1, 0); PG8_STAGE(PG8_SA(0, 1), a2 + hstep, voffA);
            PG8_WAIT_V(8); PG8_WAIT_L(0); PG8_BAR; PG8_MMA(0, 0, At, B0); PG8_MMA(0, 1, At, B1); PG8_BAR; PG8_SCHED;
            PG8_LDA(At, 1, 1); PG8_STAGE(PG8_SB(1, 0), b3, voffB); PG8_STAGE(PG8_SB(1, 1), b3 + hstep, voffB); PG8_STAGE(PG8_SA(1, 0), a3, voffA);
            PG8_WAIT_V(8); PG8_WAIT_L(0); PG8_BAR; PG8_MMA(1, 0, At, B0); PG8_MMA(1, 1, At, B1); PG8_BAR; PG8_SCHED;
        }
        if (wr == 0) PG8_BAR;
        E(acc, cur, wr, wc, fr, fq);
        if (!has_next) break;
#pragma unroll
        for (int a = 0; a < 2; ++a)
#pragma unroll
            for (int b = 0; b < 2; ++b)
#pragma unroll
                for (int m = 0; m < 4; ++m)
#pragma unroll
                    for (int n = 0; n < 2; ++n) acc[a][b][m][n] = (f32x4){0.f, 0.f, 0.f, 0.f};
        cur = nxt; cA = nA; cB = nB; ++ui;
        if (wr == 1) PG8_BAR;
    }
    PG8_WAIT_V(0);
    PG8_BAR;
#undef PG8_SA
#undef PG8_SB
#undef PG8_STAGE
#undef PG8_LDA
#undef PG8_LDB
#undef PG8_MMA
#undef PG8_WAIT_V
#undef PG8_WAIT_L
#undef PG8_BAR
#undef PG8_SCHED
}
}

#define KSWZ(row, colB) ((row) * 256 + ((colB) ^ (((row) & 15) << 4)))
#define PSWZ(row, colB) ((row) * 128 + ((colB) ^ ((((row) >> 1) & 7) << 4)))
#define SBAR() __builtin_amdgcn_sched_barrier(0)
#ifndef QK_DEP_MLA
#define QK_DEP_MLA 3
#endif
constexpr int A_V = 0, A_K = 49152, A_P = 81920, A_F = 98304, A_W = 99840, A_FLG = 101888, A_END = 101904, A_GL = 102400, A_RK = 105472, A_F2L = 121856;
__device__ __forceinline__ int v_st(int k, int c) { const int kk = (k & ~0xC) | ((k & 4) << 1) | ((k & 8) >> 1); return ((kk >> 3) * 4 + (c >> 5)) * 512 + ((kk & 7) * 32 + (c & 31)) * 2; }
__device__ __forceinline__ int v_rd_base(int lane) { return ((lane & 3) << 3) | (((lane >> 2) & 3) << 6) | (((lane >> 4) & 1) << 5) | (((lane >> 5) & 1) << 8); }
__device__ __forceinline__ int crow(int r, int hi) { return (r & 3) + 8 * (r >> 2) + 4 * hi; }
__device__ __forceinline__ float swap_sum(float v) { auto rr = __builtin_amdgcn_permlane32_swap(__float_as_uint(v), __float_as_uint(v), false, false); return __uint_as_float(rr[0]) + __uint_as_float(rr[1]); }
__device__ __forceinline__ float swap_max(float v) { auto rr = __builtin_amdgcn_permlane32_swap(__float_as_uint(v), __float_as_uint(v), false, false); return fmaxf(__uint_as_float(rr[0]), __uint_as_float(rr[1])); }

#define PK4(P, B_, OUT) do { unsigned a0 = cvt_pk_bf16(P[B_+0], P[B_+1]), a1 = cvt_pk_bf16(P[B_+2], P[B_+3]);                          \
        unsigned b0 = cvt_pk_bf16(P[B_+4], P[B_+5]), b1 = cvt_pk_bf16(P[B_+6], P[B_+7]);                                             \
        auto r0 = __builtin_amdgcn_permlane32_swap(a0, b0, false, false); auto r1 = __builtin_amdgcn_permlane32_swap(a1, b1, false, false); \
        u32x4 w = {r0[0], r1[0], r0[1], r1[1]}; OUT = __builtin_bit_cast(bf16x8, w); } while (0)

template <int MODE>
__device__ __forceinline__ void qkt(f32x16& p0, f32x16& p1, LAS const char* K_lds, LAS const char* P_lds, int kbuf, int r32, int hi, const bf16x8* qr) {
    constexpr int ND = (MODE == 2) ? 12 : 8, DEP = (MODE == 2) ? QK_DEP_MLA : 4;
    LAS const char* kbase = K_lds + kbuf * 16384;
    LAS const char* pbase = P_lds + kbuf * 8192;
    LAS const char* kb[4]; LAS const char* pb[4];
#pragma unroll
    for (int dd = 0; dd < 4; ++dd) { kb[dd] = kbase + KSWZ(r32, (dd * 16 + hi * 8) * 2); pb[dd] = pbase + PSWZ(r32, (dd * 16 + hi * 8) * 2); }
    bf16x8 kf[2 * DEP];
#define QK_LD(d, slot) do { if ((d) < 8) { LAS const char* a_ = ((d) < 4) ? kb[(d) & 3] : (LAS const char*)((unsigned)(size_t)kb[(d) & 3] ^ 128u); kf[2 * (slot)] = *(LAS const bf16x8*)a_; kf[2 * (slot) + 1] = *(LAS const bf16x8*)(a_ + 32 * 256); } \
                            else { LAS const char* a_ = pb[((d) - 8) & 3]; kf[2 * (slot)] = *(LAS const bf16x8*)a_; kf[2 * (slot) + 1] = *(LAS const bf16x8*)(a_ + 32 * 128); } } while (0)
#pragma unroll
    for (int d = 0; d < DEP; ++d) QK_LD(d, d);
    SBAR();
    const f32x16 zero = {0.f, 0.f, 0.f, 0.f, 0.f, 0.f, 0.f, 0.f, 0.f, 0.f, 0.f, 0.f, 0.f, 0.f, 0.f, 0.f};
#pragma unroll
    for (int d = 0; d < ND; ++d) {
        const int slot = d % DEP;
        if (d == 0) { p0 = __builtin_amdgcn_mfma_f32_32x32x16_bf16(kf[0], qr[0], zero, 0, 0, 0); p1 = __builtin_amdgcn_mfma_f32_32x32x16_bf16(kf[1], qr[0], zero, 0, 0, 0); }
        else { p0 = __builtin_amdgcn_mfma_f32_32x32x16_bf16(kf[2 * slot], qr[d], p0, 0, 0, 0); p1 = __builtin_amdgcn_mfma_f32_32x32x16_bf16(kf[2 * slot + 1], qr[d], p1, 0, 0, 0); }
        if (d + DEP < ND) QK_LD(d + DEP, slot);
        SBAR();
    }
#undef QK_LD
}
__device__ __forceinline__ void pv_tile(f32x16* o, int vb, bf16x8 pa0, bf16x8 pa1, bf16x8 pa2, bf16x8 pa3) {
#define TRRD(dst, off) asm volatile("ds_read_b64_tr_b16 %0, %1 offset:%2" : "=&v"(dst) : "v"(vb), "i"(off) : "memory")
#define PV_D0(d0) do { s16x4 l0, l1, l2, l3, h0, h1, h2, h3; constexpr int b_ = (d0) * 512; \
        TRRD(l0, b_); TRRD(h0, b_ + 2048); TRRD(l1, b_ + 4096); TRRD(h1, b_ + 6144); TRRD(l2, b_ + 8192); TRRD(h2, b_ + 10240); TRRD(l3, b_ + 12288); TRRD(h3, b_ + 14336); \
        asm volatile("s_waitcnt lgkmcnt(0)" ::: "memory"); SBAR();   \
        o[d0] = __builtin_amdgcn_mfma_f32_32x32x16_bf16(pa0, (bf16x8){l0[0], l0[1], l0[2], l0[3], h0[0], h0[1], h0[2], h0[3]}, o[d0], 0, 0, 0);   \
        o[d0] = __builtin_amdgcn_mfma_f32_32x32x16_bf16(pa1, (bf16x8){l1[0], l1[1], l1[2], l1[3], h1[0], h1[1], h1[2], h1[3]}, o[d0], 0, 0, 0);   \
        o[d0] = __builtin_amdgcn_mfma_f32_32x32x16_bf16(pa2, (bf16x8){l2[0], l2[1], l2[2], l2[3], h2[0], h2[1], h2[2], h2[3]}, o[d0], 0, 0, 0);   \
        o[d0] = __builtin_amdgcn_mfma_f32_32x32x16_bf16(pa3, (bf16x8){l3[0], l3[1], l3[2], l3[3], h3[0], h3[1], h3[2], h3[3]}, o[d0], 0, 0, 0); } while (0)
    PV_D0(0); PV_D0(1); PV_D0(2); PV_D0(3);
#undef PV_D0
#undef TRRD
}

template <int MODE>
__device__ __forceinline__ void attn_unit(LAS char* lds, const bf16_t* Qp, int ldq, const bf16_t* Kp, int ldk, const bf16_t* Vp, int ldv, bf16_t* Op, int ldo, const float* F2, int qb, float C2,
               const float* g1, const float* g2, const float* kss, int kss_ld, const float* sspe, const int* posb, const bf16_t* Kpe, bool fresh_tables) {
    constexpr int NQ = (MODE == 2) ? 12 : 8;
    int tid_l = threadIdx.x; asm volatile("" : "+v"(tid_l));
    const int tid = tid_l, wid = __builtin_amdgcn_readfirstlane(tid >> 6), lane = tid & 63, r32 = lane & 31, hi = lane >> 5;
    const bool grpB = wid >= 4;
    const int q0 = qb * 256, NT = 4 * qb + 4;
    const int qlo = q0 + wid * 32, tq = qlo + r32;
    LAS char* V_lds = lds + A_V; LAS char* K_lds = lds + A_K; LAS char* P_lds = lds + A_P; LAS float* F_lds = (LAS float*)(lds + A_F);
    LAS float* wsf = (LAS float*)(lds + A_W) + wid * 64; LAS float* li_l = wsf; LAS float* al_l = wsf + 32;
    LAS const float* GL = (LAS const float*)(lds + A_GL);
    const int sr = tid >> 4, sc = (tid & 15) * 8;
    const int vst0 = v_st(sr, sc), vst1 = v_st(32 + sr, sc), kws = KSWZ(sr, sc * 2);
    const int pr = tid >> 3, pc = (tid & 7) * 8, pws = PSWZ(pr, pc * 2);
    const int vb0 = (int)(size_t)V_lds + v_rd_base(lane);
    bf16x8 qr[NQ];
    {
        const bf16_t* qrow = Qp + (size_t)tq * ldq + hi * 8;
#pragma unroll
        for (int d0 = 0; d0 < NQ; ++d0) qr[d0] = *(const GAS bf16x8*)(qrow + d0 * 16);
    }
    float f2t = 0.f; if constexpr (MODE == 1) f2t = *(const GAS float*)(F2 + tq);
    bf16x8 st_k0, st_k1, st_v0, st_v1, st_kp;
#define JT(t) ((MODE == 0) ? (NT - 1 - (t)) : (t))
#define SLOAD(j) do { const int k0_ = (j) * 64; \
        st_k0 = *(const GAS bf16x8*)(Kp + (size_t)(k0_ + sr) * ldk + sc); st_k1 = *(const GAS bf16x8*)(Kp + (size_t)(k0_ + 32 + sr) * ldk + sc); \
        st_v0 = *(const GAS bf16x8*)(Vp + (size_t)(k0_ + sr) * ldv + sc); st_v1 = *(const GAS bf16x8*)(Vp + (size_t)(k0_ + 32 + sr) * ldv + sc); \
        if constexpr (MODE == 2) { st_kp = *(const GAS bf16x8*)(Kpe + (size_t)(k0_ + pr) * 64 + pc); } } while (0)
#define SWRITE(kbf, vbf) do { *(LAS bf16x8*)(K_lds + (kbf) * 16384 + kws) = st_k0; *(LAS bf16x8*)(K_lds + (kbf) * 16384 + kws + 32 * 256) = st_k1; \
        *(LAS bf16x8*)(V_lds + (vbf) * 16384 + vst0) = st_v0; *(LAS bf16x8*)(V_lds + (vbf) * 16384 + vst1) = st_v1; \
        if constexpr (MODE == 2) *(LAS bf16x8*)(P_lds + (kbf) * 8192 + pws) = st_kp; \
        } while (0)
    float m_reg = -1e30f, l_reg = 0.f, Rc = 0.f; bool wdone = false, stop = false, pend = false;
    int pj = 0, pv3 = 0;
    LAS int* flg = (LAS int*)(lds + A_FLG);
    if constexpr (MODE == 0) { if (tid < 4) flg[tid] = 0; }
    const float m0 = hi == 0 ? 1.f : 0.f;

    SLOAD(JT(0));
    LAS float* RK = (LAS float*)(lds + A_RK); LAS float* F2L = (LAS float*)(lds + A_F2L);
    if constexpr (MODE != 0) {
        if (fresh_tables) {
            const int nk = q0 + 256;
            float rv[8], sv[8], fv[8];
#pragma unroll
            for (int i = 0; i < 8; ++i) { const int k = tid + 512 * i; rv[i] = 1.f; sv[i] = 0.f; fv[i] = 0.f;
                if (k < nk) { rv[i] = *(const GAS float*)(kss + (size_t)k * kss_ld);
                    if constexpr (MODE == 2) sv[i] = *(const GAS float*)(sspe + k);
                    if constexpr (MODE == 1) fv[i] = *(const GAS float*)(F2 + k); } }
#pragma unroll
            for (int i = 0; i < 8; ++i) { const int k = tid + 512 * i;
                if (k < nk) { RK[k] = C2 / sqrtf((rv[i] + sv[i]) * ((MODE == 1) ? (1.0f / 128.f) : (1.0f / 192.f)) + EPS);
                    if constexpr (MODE == 1) F2L[k] = fv[i]; } }
        }
    }
    if constexpr (MODE == 1) {
        float ss = 0.f;
#pragma unroll
        for (int d0 = 0; d0 < 8; ++d0)
#pragma unroll
            for (int e = 0; e < 8; ++e) { const float f = bf2f(qr[d0][e]); ss += f * f; }
        ss = swap_sum(ss);
        const float rstd = 1.0f / sqrtf(ss * (1.0f / 128.f) + EPS);
#pragma unroll
        for (int d0 = 0; d0 < 8; ++d0) { const int d = d0 * 16 + hi * 8;
            const f32x4 ga = *(LAS const f32x4*)(GL + d), gb = *(LAS const f32x4*)(GL + d + 4);
            float f[8];
#pragma unroll
            for (int e = 0; e < 4; ++e) { f[e] = bf2f(qr[d0][e]) * rstd * ga[e]; f[4 + e] = bf2f(qr[d0][4 + e]) * rstd * gb[e]; }
            u32x4 w; w.x = cvt_pk_bf16(f[0], f[1]); w.y = cvt_pk_bf16(f[2], f[3]); w.z = cvt_pk_bf16(f[4], f[5]); w.w = cvt_pk_bf16(f[6], f[7]);
            qr[d0] = __builtin_bit_cast(bf16x8, w); }
    }
    if constexpr (MODE == 2) {
        float ss = 0.f;
#pragma unroll
        for (int d0 = 0; d0 < 12; ++d0)
#pragma unroll
            for (int e = 0; e < 8; ++e) { const float f = bf2f(qr[d0][e]); ss += f * f; }
        ss = swap_sum(ss);
        const float rstd = 1.0f / sqrtf(ss * (1.0f / 192.f) + EPS);
#pragma unroll
        for (int d0 = 0; d0 < 8; ++d0) { const int d = d0 * 16 + hi * 8;
            const f32x4 ga = *(LAS const f32x4*)(GL + d), gb = *(LAS const f32x4*)(GL + d + 4);
            float f[8];
#pragma unroll
            for (int e = 0; e < 4; ++e) { f[e] = bf2f(qr[d0][e]) * rstd * ga[e]; f[4 + e] = bf2f(qr[d0][4 + e]) * rstd * gb[e]; }
            u32x4 w; w.x = cvt_pk_bf16(f[0], f[1]); w.y = cvt_pk_bf16(f[2], f[3]); w.z = cvt_pk_bf16(f[4], f[5]); w.w = cvt_pk_bf16(f[6], f[7]);
            qr[d0] = __builtin_bit_cast(bf16x8, w); }
        const float posf = (float)*(const GAS int*)(posb + tq);
#pragma unroll
        for (int f = 0; f < 2; ++f) { const int d1 = 128 + 16 * f + hi * 8, d2 = d1 + 32;
            const f32x4 ga = *(LAS const f32x4*)(GL + d1), gb = *(LAS const f32x4*)(GL + d1 + 4), ha = *(LAS const f32x4*)(GL + d2), hb = *(LAS const f32x4*)(GL + d2 + 4);
            const f32x4 iva = *(LAS const f32x4*)(GL + 512 + 16 * f + 8 * hi), ivb = *(LAS const f32x4*)(GL + 512 + 16 * f + 8 * hi + 4);
            float o1[8], o2[8];
#pragma unroll
            for (int e = 0; e < 8; ++e) {
                const float t1 = bf2f(qr[8 + f][e]) * rstd * (e < 4 ? ga[e & 3] : gb[e & 3]);
                const float t2 = bf2f(qr[10 + f][e]) * rstd * (e < 4 ? ha[e & 3] : hb[e & 3]);
                const float inv = (e < 4 ? iva[e & 3] : ivb[e & 3]);
                const float ang = posf * inv;
                const float kq = rintf(ang * 0.15915494309189535f);
                float rr = fmaf(-kq, 6.28125f, ang); rr = fmaf(-kq, 1.9353071795864769e-3f, rr);
                const float sn = __sinf(rr), cs = __cosf(rr);
                o1[e] = t1 * cs - t2 * sn; o2[e] = t2 * cs + t1 * sn;
            }
            u32x4 w1, w2;
            w1.x = cvt_pk_bf16(o1[0], o1[1]); w1.y = cvt_pk_bf16(o1[2], o1[3]); w1.z = cvt_pk_bf16(o1[4], o1[5]); w1.w = cvt_pk_bf16(o1[6], o1[7]);
            w2.x = cvt_pk_bf16(o2[0], o2[1]); w2.y = cvt_pk_bf16(o2[2], o2[3]); w2.z = cvt_pk_bf16(o2[4], o2[5]); w2.w = cvt_pk_bf16(o2[6], o2[7]);
            qr[8 + f] = __builtin_bit_cast(bf16x8, w1); qr[10 + f] = __builtin_bit_cast(bf16x8, w2); }
    }
    f32x16 o[4]; f32x16 p0, p1;
#pragma unroll
    for (int d = 0; d < 4; ++d)
#pragma unroll
        for (int r = 0; r < 16; ++r) o[d][r] = 0.f;
#pragma unroll
    for (int r = 0; r < 16; ++r) { p0[r] = 0.f; p1[r] = 0.f; }
    SWRITE(0, 0); __syncthreads();

#define SBHALF(P, coff, carry_in, run_out) do { f32x16 lq; \
        _Pragma("unroll") for (int r = 0; r < 16; ++r) { const float z = P[r] * C2; const float e = __builtin_amdgcn_exp2f(-fabsf(z)); const float L = __builtin_amdgcn_logf(1.f + e); const float lb = fminf(z, 0.f) - L; P[r] = lb; lq[r] = lb - z; } \
        if (needmask) { const float NEG = -__builtin_inff(); \
            _Pragma("unroll") for (int r = 0; r < 16; ++r) { const int c = (r & 3) + 8 * (r >> 2) + (coff); if (dq - c <= 0) { P[r] = NEG; lq[r] = 0.f; } } } \
        float mn_[4], pr_[4], th_[4], bs_[4]; \
        _Pragma("unroll") for (int i = 0; i < 4; ++i) mn_[i] = (lq[4*i] + lq[4*i+1]) + (lq[4*i+2] + lq[4*i+3]); \
        _Pragma("unroll") for (int i = 0; i < 4; ++i) { auto rr = __builtin_amdgcn_permlane32_swap(__float_as_uint(mn_[i]), __float_as_uint(mn_[i]), false, false); \
            pr_[i] = __uint_as_float(rr[0]) + __uint_as_float(rr[1]); th_[i] = __uint_as_float(rr[1]) * m0; } \
        float run = (carry_in); \
        _Pragma("unroll") for (int i = 3; i >= 0; --i) { bs_[i] = run + th_[i]; run += pr_[i]; } \
        _Pragma("unroll") for (int i = 0; i < 4; ++i) { float s = bs_[i]; \
            const float w3 = __builtin_amdgcn_exp2f(P[4*i+3] + s); s += lq[4*i+3]; const float w2 = __builtin_amdgcn_exp2f(P[4*i+2] + s); s += lq[4*i+2]; \
            const float w1 = __builtin_amdgcn_exp2f(P[4*i+1] + s); s += lq[4*i+1]; const float w0 = __builtin_amdgcn_exp2f(P[4*i] + s); \
            P[4*i] = w0; P[4*i+1] = w1; P[4*i+2] = w2; P[4*i+3] = w3; } \
        run_out = run; } while (0)

#define SMPV(j_, v3_) do { const int kb_ = (j_) * 64; bf16x8 pa0, pa1, pa2, pa3; \
        const bool needmask = kb_ + 63 >= qlo; const int dq = tq - kb_ - 4 * hi; \
        if constexpr (MODE == 0) { \
            float r1_, r0_; \
            SBHALF(p1, 32, Rc, r1_); SBHALF(p0, 0, r1_, r0_); \
            Rc = r0_; wdone = __all(Rc < -160.f); \
        } else { \
            if constexpr (MODE == 1) { \
                _Pragma("unroll") for (int i = 0; i < 4; ++i) { const f32x4 fa = *(LAS const f32x4*)(F2L + kb_ + 8 * i + 4 * hi); const f32x4 fb = *(LAS const f32x4*)(F2L + kb_ + 32 + 8 * i + 4 * hi); \
                    const f32x4 ra = *(LAS const f32x4*)(RK + kb_ + 8 * i + 4 * hi); const f32x4 rb = *(LAS const f32x4*)(RK + kb_ + 32 + 8 * i + 4 * hi); \
                    _Pragma("unroll") for (int u = 0; u < 4; ++u) { p0[4*i+u] = fmaf(p0[4*i+u], ra[u], f2t - fa[u]); p1[4*i+u] = fmaf(p1[4*i+u], rb[u], f2t - fb[u]); } } \
            } else { \
                _Pragma("unroll") for (int i = 0; i < 4; ++i) { const f32x4 ra = *(LAS const f32x4*)(RK + kb_ + 8 * i + 4 * hi); const f32x4 rb = *(LAS const f32x4*)(RK + kb_ + 32 + 8 * i + 4 * hi); \
                    _Pragma("unroll") for (int u = 0; u < 4; ++u) { p0[4*i+u] *= ra[u]; p1[4*i+u] *= rb[u]; } } \
            } \
            if (needmask) { const float NEG = -__builtin_inff(); \
                _Pragma("unroll") for (int r = 0; r < 16; ++r) { const int c = (r & 3) + 8 * (r >> 2); if (dq - c < 0) p0[r] = NEG; if (dq - c - 32 < 0) p1[r] = NEG; } } \
            float pma = fmaxf(fmaxf(p0[0], p0[1]), p1[0]), pmb = fmaxf(fmaxf(p0[2], p0[3]), p1[1]); pma = fmaxf(fmaxf(pma, p1[2]), p1[3]); \
            _Pragma("unroll") for (int r = 4; r < 16; r += 4) { pma = fmaxf(fmaxf(pma, p0[r]), p0[r+1]); pmb = fmaxf(fmaxf(pmb, p0[r+2]), p0[r+3]); pma = fmaxf(fmaxf(pma, p1[r]), p1[r+1]); pmb = fmaxf(fmaxf(pmb, p1[r+2]), p1[r+3]); } \
            float pmax = swap_max(fmaxf(pma, pmb)); \
            const float SC = 1.f; \
            float mn, alpha; \
            if (__all(pmax - m_reg <= 11.5f)) { mn = m_reg; alpha = 1.f; } else { mn = fmaxf(m_reg, pmax); alpha = __builtin_amdgcn_exp2f(m_reg - mn); m_reg = mn; } \
            float psa = 0.f, psb = 0.f; const float nmn = -mn; \
            _Pragma("unroll") for (int r = 0; r < 16; ++r) { p0[r] = __builtin_amdgcn_exp2f(fmaf(p0[r], SC, nmn)); p1[r] = __builtin_amdgcn_exp2f(fmaf(p1[r], SC, nmn)); psa += p0[r]; psb += p1[r]; } \
            const float ps = swap_sum(psa + psb); l_reg = l_reg * alpha + ps; \
            if (__any(alpha < 1.f)) { if (hi == 0) al_l[r32] = alpha; asm volatile("s_waitcnt lgkmcnt(0)" ::: "memory"); \
                _Pragma("unroll") for (int r = 0; r < 16; ++r) { const float a_ = al_l[crow(r, hi)]; o[0][r] *= a_; o[1][r] *= a_; o[2][r] *= a_; o[3][r] *= a_; } \
                asm volatile("s_waitcnt lgkmcnt(0)" ::: "memory"); } \
        } \
        PK4(p0, 0, pa0); PK4(p0, 8, pa1); PK4(p1, 0, pa2); PK4(p1, 8, pa3); \
        SBAR(); pv_tile(o, vb0 + (v3_) * 16384, pa0, pa1, pa2, pa3); } while (0)

    int k2 = 0, v3 = 0;
    if (grpB) __builtin_amdgcn_s_setprio(1);
#pragma nounroll
    for (int t = 0; t <= NT; ++t) {
        const bool more = t < NT;
        const int j = JT(t), kb = j * 64;
        if (t + 1 < NT) SLOAD(JT(t + 1));
        const bool inrange = more && (kb <= qlo + 31);
        if (!grpB && inrange && !wdone) { qkt<MODE>(p0, p1, K_lds, P_lds, k2, r32, hi, qr); pend = true; pj = j; pv3 = v3; }
        if (pend) { SMPV(pj, pv3); pend = false; }
        if (grpB && inrange && !wdone) { qkt<MODE>(p0, p1, K_lds, P_lds, k2, r32, hi, qr); pend = true; pj = j; pv3 = v3; }
        const int k2n = k2 ^ 1, v3n = (v3 == 2) ? 0 : v3 + 1;
        if constexpr (MODE == 0) { if ((!wdone || pend) && lane == 0) flg[v3] = 1; }
        if (t + 1 < NT) { SWRITE(k2n, v3n); }
        __syncthreads();
        if constexpr (MODE == 0) { const int any_ = flg[v3]; if (tid == 0) flg[(v3n == 2) ? 0 : v3n + 1] = 0; if (!any_) stop = true; }
        k2 = k2n; v3 = v3n;
        if (stop) break;
    }

    __builtin_amdgcn_s_setprio(0);
    float rli[16];
    if constexpr (MODE == 0) {
#pragma unroll
        for (int r = 0; r < 16; ++r) rli[r] = 1.f;
    } else {
        if (hi == 0) li_l[r32] = l_reg; asm volatile("s_waitcnt lgkmcnt(0)" ::: "memory");
#pragma unroll
        for (int r = 0; r < 16; ++r) rli[r] = 1.0f / li_l[crow(r, hi)];
        asm volatile("s_waitcnt lgkmcnt(0)" ::: "memory");
    }
    bf16_t* Ow = Op + (size_t)qlo * ldo;
    LAS bf16_t* stg = (LAS bf16_t*)(lds + wid * 8192);
#pragma unroll
    for (int r = 0; r < 16; ++r) { const int orow = crow(r, hi);
#pragma unroll
        for (int d0 = 0; d0 < 4; ++d0) { const float v = o[d0][r] * rli[r]; stg[orow * 128 + d0 * 32 + r32] = (bf16_t)(cvt_pk_bf16(v, v) & 0xffffu); } }
    asm volatile("s_waitcnt lgkmcnt(0)" ::: "memory");
#pragma unroll
    for (int i = 0; i < 8; ++i) { const int row = i * 4 + (lane >> 4), ch = lane & 15;
        const u32x4 v = *(LAS const u32x4*)(stg + row * 128 + ch * 8);
        *(GAS u32x4*)(Ow + (size_t)row * ldo + ch * 8) = v; }
    __syncthreads();
#undef JT
#undef SLOAD
#undef SWRITE
#undef SMPV
#undef SBHALF
}


#define XB_TMO      128
#define XB_XCNT(j)  (256  + 64 * (j))
#define XB_XSUB(j)  (1280 + 64 * (j))
#define XB_XGEN(j)  (2304 + 64 * (j))
#define XB_TOP      3328
#define XB_TOPGEN   3392
#define XCD_BAR_WORDS 3456
#define XB_SPIN_CAP (1u << 18)

__device__ __forceinline__ unsigned xb_ld(unsigned* p)              { return __hip_atomic_load(p, __ATOMIC_RELAXED, __HIP_MEMORY_SCOPE_AGENT); }
__device__ __forceinline__ unsigned xb_add(unsigned* p, unsigned v) { return __hip_atomic_fetch_add(p, v, __ATOMIC_RELAXED, __HIP_MEMORY_SCOPE_AGENT); }
__device__ __forceinline__ unsigned xb_xcc_id() { return (unsigned)__builtin_amdgcn_s_getreg((3 << 11) | 20) & 0xFu; }
#define XB_SPIN(cond, bar) do { unsigned _sp = 0; while (cond) { __builtin_amdgcn_s_sleep(1); \
    if ((++_sp & 255u) == 0u) { if (xb_ld(&(bar)[XB_TMO])) break; if (_sp > XB_SPIN_CAP) { atomicAdd(&(bar)[XB_TMO], 1u); break; } } } } while (0)

struct XcdBarrier {
    unsigned* bar; unsigned x;
    volatile LAS unsigned* st;
};

__device__ __forceinline__ XcdBarrier xcd_barrier_post(unsigned* bar, volatile LAS unsigned* st) {
    XcdBarrier b; b.bar = bar; b.x = xb_xcc_id(); b.st = st;
    if (threadIdx.x == 0) (void)xb_add(&bar[XB_XCNT(b.x)], 1u);
    return b;
}
__device__ __forceinline__ void xcd_barrier_complete(unsigned* bar, unsigned x, unsigned& nloc, unsigned& nx) {
    const unsigned G = gridDim.x * gridDim.y * gridDim.z;
    unsigned sum, cnt, mine, sp = 0u;
    for (;;) {
        sum = 0u; cnt = 0u; mine = 0u;
#pragma unroll
        for (unsigned j = 0; j < 16; ++j) { const unsigned c = xb_ld(&bar[XB_XCNT(j)]); sum += c; cnt += (c > 0u) ? 1u : 0u; mine = (j == x) ? c : mine; }
        if (sum == G) break;
        __builtin_amdgcn_s_sleep(1);
        if ((++sp & 255u) == 0u) { if (xb_ld(&bar[XB_TMO])) break; if (sp > XB_SPIN_CAP) { atomicAdd(&bar[XB_TMO], 1u); break; } }
    }
    nloc = mine > 0u ? mine : 1u; nx = cnt > 0u ? cnt : 1u;
}

__device__ __forceinline__ void xcd_barrier(const XcdBarrier& b) {
    asm volatile("s_waitcnt vmcnt(0)" ::: "memory");
    __syncthreads();
    if (threadIdx.x == 0) {
        unsigned* bar = b.bar;
        __builtin_amdgcn_s_waitcnt(0);
        unsigned nloc = b.st[0], nx = b.st[1];
        if (nloc == 0u) { xcd_barrier_complete(bar, b.x, nloc, nx); b.st[0] = nloc; b.st[1] = nx; }
        const unsigned old = xb_add(&bar[XB_XSUB(b.x)], 1u);
        const unsigned gen = old / nloc;
        if (old + 1u == (gen + 1u) * nloc) {
            __builtin_amdgcn_fence(__ATOMIC_RELEASE, "agent");
            asm volatile("s_waitcnt vmcnt(0)" ::: "memory");
            const unsigned og = xb_add(&bar[XB_TOP], 1u);
            const unsigned tg = og / nx;
            if (og + 1u == (tg + 1u) * nx) xb_add(&bar[XB_TOPGEN], 1u);
            else XB_SPIN(xb_ld(&bar[XB_TOPGEN]) == tg, bar);
            __builtin_amdgcn_fence(__ATOMIC_ACQUIRE, "agent");
            xb_add(&bar[XB_XGEN(b.x)], 1u);
            asm volatile("s_waitcnt vmcnt(0)" ::: "memory");
        } else {
            XB_SPIN(xb_ld(&bar[XB_XGEN(b.x)]) == gen, bar);
            __builtin_amdgcn_fence(__ATOMIC_ACQUIRE, "agent");
            asm volatile("s_waitcnt vmcnt(0)" ::: "memory");
        }
    }
    __syncthreads();
}

struct Params {
    const float* x; const int* pos; const float* ln_mix_g; const float* ln_mlp_g; const float* w_in; const float* b_f; const float* fox_q_g; const float* fox_k_g; const float* w_o0;
    const float* mla_w_down; const float* q_a_g; const float* kv_a_g; const float* w_uq; const float* w_ukv; const float* mla_q_g; const float* mla_k_g; const float* w_o1;
    const float* w_up; const float* w_dn; float* out; unsigned char* ws;
};

__device__ __forceinline__ void transpose_block_item(const float* W, int K, int N, int ldw, const float* g, bf16_t* WT, LAS float* tile, int item, int tid) {
    const int nblk = (N + 255) / 256, kb = item / nblk, nb = item % nblk, k0 = 64 * kb, n0 = 256 * nb;
    const int rr = tid >> 6, c4 = (tid & 63) * 4;
    const bool colok = n0 + c4 < N;
    f32x4 tv[8];
#pragma unroll
    for (int i = 0; i < 8; ++i) tv[i] = colok ? *(const GAS f32x4*)(W + (size_t)(k0 + i * 8 + rr) * ldw + n0 + c4) : (f32x4){0.f, 0.f, 0.f, 0.f};
    if (g) {
#pragma unroll
        for (int i = 0; i < 8; ++i) tv[i] = tv[i] * *(const GAS float*)(g + k0 + i * 8 + rr);
    }
#pragma unroll
    for (int i = 0; i < 8; ++i) *(LAS f32x4*)(tile + (i * 8 + rr) * 260 + c4) = tv[i];
    __syncthreads();
    const int n = tid >> 1, kh = (tid & 1) * 32;
    if (n0 + n < N) {
        float f[32];
#pragma unroll
        for (int j = 0; j < 32; ++j) f[j] = tile[(kh + j) * 260 + n];
        bf16_t* dst = WT + (size_t)(n0 + n) * K + k0 + kh;
#pragma unroll
        for (int q = 0; q < 4; ++q) { u32x4 o; o.x = cvt_pk_bf16(f[8 * q], f[8 * q + 1]); o.y = cvt_pk_bf16(f[8 * q + 2], f[8 * q + 3]); o.z = cvt_pk_bf16(f[8 * q + 4], f[8 * q + 5]); o.w = cvt_pk_bf16(f[8 * q + 6], f[8 * q + 7]);
            *(GAS u32x4*)(dst + 8 * q) = o; }
    }
    __syncthreads();
}

__device__ __forceinline__ void transpose_item(const float* W, int K, int N, int ldw, const float* g, bf16_t* WT, LAS float* scr, int item, int lane) {
    const int nblk = N / 32, kb = item / nblk, nb = item % nblk, k0 = 64 * kb, n0 = 32 * nb;
    float tv[32];
    const float* wp = W + (size_t)(k0 + (lane >> 5)) * ldw + n0 + (lane & 31);
#pragma unroll
    for (int i = 0; i < 32; ++i) tv[i] = wp[(size_t)(2 * i) * ldw];
    if (g) {
#pragma unroll
        for (int i = 0; i < 32; ++i) tv[i] *= g[k0 + 2 * i + (lane >> 5)];
    }
#pragma unroll
    for (int i = 0; i < 32; ++i) scr[(2 * i + (lane >> 5)) * 33 + (lane & 31)] = tv[i];
    asm volatile("s_waitcnt lgkmcnt(0)" ::: "memory");
    const int c = lane & 7;
#pragma unroll
    for (int j = 0; j < 4; ++j) { const int n = (lane >> 3) + 8 * j; const LAS float* s = scr + (8 * c) * 33 + n;
        u32x4 o; o.x = cvt_pk_bf16(s[0 * 33], s[1 * 33]); o.y = cvt_pk_bf16(s[2 * 33], s[3 * 33]); o.z = cvt_pk_bf16(s[4 * 33], s[5 * 33]); o.w = cvt_pk_bf16(s[6 * 33], s[7 * 33]);
        *(u32x4*)(WT + (size_t)(n0 + n) * K + k0 + 8 * c) = o; }
    asm volatile("s_waitcnt lgkmcnt(0)" ::: "memory");
}

__global__ void __launch_bounds__(512) mega_fwd(Params p) {
    extern __shared__ __attribute__((aligned(16))) unsigned char lds_raw[];
    LAS unsigned char* lds = (LAS unsigned char*)lds_raw;
    cg::grid_group grid = cg::this_grid();
    const int G = gridDim.x, bx = blockIdx.x; const int vcu = (G % 8 == 0) ? (bx % 8) * (G / 8) + bx / 8 : bx;
    const int NGW = G * 8;
    volatile LAS unsigned* bst = (volatile LAS unsigned*)(lds + LDS_BYTES - 16);
    if (threadIdx.x < 4) bst[threadIdx.x] = 0u;
    __syncthreads();
    const XcdBarrier xbar = xcd_barrier_post((unsigned*)(p.ws + WS_BAR), bst);
    if (p.ws == nullptr) grid.sync();
#pragma nounroll
    for (int step = 0; step < 15; ++step) {
        if (step == 2 || step == 10) continue;
        for (int rep = 0; rep < 1 + ((DUP_MASK >> step) & 1); ++rep) {
        int tid_l = threadIdx.x; asm volatile("" : "+v"(tid_l));
        const int tid = tid_l, lane = tid & 63, wave = __builtin_amdgcn_readfirstlane(tid >> 6);
        const int gw = vcu * 8 + wave;
        unsigned char* ws = p.ws; asm volatile("" : "+s"(ws));
        float* RS = (float*)(ws + WS_RS); float* RS0 = RS, *RS1 = RS + M, *RS2 = RS + 2 * M, *RS3 = RS + 3 * M, *RSQ = RS + 4 * M, *RSKV = RS + 5 * M;
        float* LF = (float*)(ws + WS_LF); float* F2 = (float*)(ws + WS_F2); float* KPE = (float*)(ws + WS_KPE);
        bf16_t* XB = (bf16_t*)(ws + WS_XB);
        bf16_t* Q0 = (bf16_t*)(ws + WS_Q0); bf16_t* K0 = (bf16_t*)(ws + WS_K0); bf16_t* V0 = (bf16_t*)(ws + WS_V0); bf16_t* HB = (bf16_t*)(ws + WS_H);
        bf16_t* Q1 = (bf16_t*)(ws + WS_Q1); bf16_t* K1 = (bf16_t*)(ws + WS_K1); bf16_t* V1 = (bf16_t*)(ws + WS_V1);
        float* KSS0 = (float*)(ws + WS_KSS0); float* KSS1 = (float*)(ws + WS_KSS1); bf16_t* KPR = (bf16_t*)(ws + WS_KPR); float* SSPE = (float*)(ws + WS_SSPE);
        bf16_t* AO0 = (bf16_t*)(ws + WS_AO0); bf16_t* CQ = (bf16_t*)(ws + WS_CQ); bf16_t* CKV = (bf16_t*)(ws + WS_CKV); bf16_t* AO1 = (bf16_t*)(ws + WS_AO1);
        if (step == 0) {
            LAS float* scr = (LAS float*)(lds + wave * 8448);
            LAS float* wfg = (LAS float*)(lds + 67584);
            for (int idx = tid; idx < 16384; idx += 512) { const int k = idx >> 3, j = idx & 7; wfg[j * 2048 + k] = p.w_in[(size_t)k * INW + 6144 + j] * p.ln_mix_g[k]; }
            for (int i = bx * 512 + tid; i < 5 * M; i += G * 512) RS1[i] = 0.f;
            for (int i = bx * 512 + tid; i < 8 * M; i += G * 512) KSS0[i] = 0.f;
            for (int i = bx * 512 + tid; i < 16 * M; i += G * 512) KSS1[i] = 0.f;
            __syncthreads();
            constexpr int I_IN = 32 * 24, I_O = 32 * 8, I_UP = 32 * 32, I_DN = 128 * 8, I_MD = 32 * 5, I_UQ = 8 * 12, I_UKV = 8 * 16;
            constexpr int NITEMS = I_IN + 2 * I_O + 2 * I_UP + 2 * I_DN + I_MD + I_UQ + I_UKV;
            LAS float* tile = (LAS float*)lds;
            for (int it = vcu; it < NITEMS; it += G) {
                int r = it;
                if (r < I_IN) { transpose_block_item(p.w_in, 2048, 6144, INW, p.ln_mix_g, (bf16_t*)(ws + WS_WIN), tile, r, tid); continue; } r -= I_IN;
                if (r < I_O) { transpose_block_item(p.w_o0, 2048, 2048, 2048, nullptr, (bf16_t*)(ws + WS_WO0), tile, r, tid); continue; } r -= I_O;
                if (r < I_UP) { transpose_block_item(p.w_up, 2048, 8192, 8192, p.ln_mlp_g, (bf16_t*)(ws + WS_WUP0), tile, r, tid); continue; } r -= I_UP;
                if (r < I_DN) { transpose_block_item(p.w_dn, 8192, 2048, 2048, nullptr, (bf16_t*)(ws + WS_WDN0), tile, r, tid); continue; } r -= I_DN;
                if (r < I_MD) { transpose_block_item(p.mla_w_down, 2048, 1088, 1088, p.ln_mix_g + 2048, (bf16_t*)(ws + WS_WMD), tile, r, tid); continue; } r -= I_MD;
                if (r < I_UQ) { transpose_block_item(p.w_uq, 512, 3072, 3072, p.q_a_g, (bf16_t*)(ws + WS_WUQ), tile, r, tid); continue; } r -= I_UQ;
                if (r < I_UKV) { transpose_block_item(p.w_ukv, 512, 4096, 4096, p.kv_a_g, (bf16_t*)(ws + WS_WUKV), tile, r, tid); continue; } r -= I_UKV;
                if (r < I_O) { transpose_block_item(p.w_o1, 2048, 2048, 2048, nullptr, (bf16_t*)(ws + WS_WO1), tile, r, tid); continue; } r -= I_O;
                if (r < I_UP) { transpose_block_item(p.w_up + (size_t)2048 * 8192, 2048, 8192, 8192, p.ln_mlp_g + 2048, (bf16_t*)(ws + WS_WUP1), tile, r, tid); continue; } r -= I_UP;
                transpose_block_item(p.w_dn + (size_t)8192 * 2048, 8192, 2048, 2048, nullptr, (bf16_t*)(ws + WS_WDN1), tile, r, tid);
            }
            __syncthreads();
            for (int m = gw; m < M; m += NGW) {
                const f32x4* xr = (const f32x4*)(p.x + (size_t)m * DM) + lane;
                f32x4 v[8]; float ss = 0.f;
#pragma unroll
                for (int c = 0; c < 8; ++c) { v[c] = xr[64 * c]; ss += (v[c][0] * v[c][0] + v[c][1] * v[c][1]) + (v[c][2] * v[c][2] + v[c][3] * v[c][3]); }
                float d[8];
#pragma unroll
                for (int j = 0; j < 8; ++j) { float a = 0.f;
#pragma unroll
                    for (int c = 0; c < 8; ++c) { const f32x4 w = *(LAS const f32x4*)(wfg + j * 2048 + c * 256 + lane * 4); a += (v[c][0] * w[0] + v[c][1] * w[1]) + (v[c][2] * w[2] + v[c][3] * w[3]); }
                    d[j] = wave_sum(a); }
                ss = wave_sum(ss);
                const float rstd = 1.0f / sqrtf(ss * (1.0f / DM) + EPS);
                if (lane == 0) RS0[m] = ss;
                if (lane < 8) { float dj = d[0];
#pragma unroll
                    for (int j = 1; j < 8; ++j) dj = (lane == j) ? d[j] : dj;
                    const float lg = dj * rstd + p.b_f[lane]; const float ls = fminf(lg, 0.f) - log1pf(expf(-fabsf(lg)));
                    LF[((size_t)(m / SEQ) * 8 + lane) * SEQ + (m % SEQ)] = ls * LOG2E; }
#pragma unroll
                for (int c = 0; c < 8; ++c) { u32x2 w; w.x = cvt_pk_bf16(v[c][0], v[c][1]); w.y = cvt_pk_bf16(v[c][2], v[c][3]); *(u32x2*)(XB + (size_t)m * DM + c * 256 + lane * 4) = w; }
            }
        } else if (step == 3) {
            const float C2 = 0.08838834764831845f * LOG2E;
            { LAS float* GLw = (LAS float*)(lds + A_GL); if (tid < 128) GLw[tid] = p.fox_q_g[tid] * p.fox_k_g[tid]; __syncthreads(); }
            for (int L = vcu; L < 512; L += G) {
                const int i = L >> 8, c = L & 255, b = c >> 6, h8 = (c >> 3) & 7, pp = c & 7, hh = i * 8 + h8;
                const size_t hoff = (size_t)b * SEQ * DM + hh * 128;
                for (int pass = 0; pass < 2; ++pass) {
                    const int qb = pass ? pp : 15 - pp;
#ifndef NO_SB
                    if (i == 0) attn_unit<0>((LAS char*)lds, Q0 + hoff, DM, K0 + hoff, DM, V0 + hoff, DM, AO0 + hoff, DM, nullptr, qb, C2, nullptr, nullptr, nullptr, 0, nullptr, nullptr, nullptr, true);
#endif
#ifndef NO_FOX
                    if (i != 0) attn_unit<1>((LAS char*)lds, Q0 + hoff, DM, K0 + hoff, DM, V0 + hoff, DM, AO0 + hoff, DM, F2 + (size_t)(b * 8 + h8) * SEQ, qb, C2,
                                             p.fox_q_g, p.fox_k_g, KSS0 + (size_t)b * SEQ * 8 + h8, 8, nullptr, nullptr, nullptr, pass == 0);
#endif
                }
            }
        } else if (step == 11) {
            const float C2 = 0.07216878364870322f * LOG2E;
            { LAS float* GLw = (LAS float*)(lds + A_GL); if (tid < 192) GLw[tid] = p.mla_q_g[tid] * (tid < 128 ? p.mla_k_g[tid] : 1.0f);
              if (tid < 32) GLw[512 + tid] = exp2f(-(float)tid * (13.287712379549449f / 32.0f)); __syncthreads(); }
            for (int L = vcu; L < 512; L += G) {
                const int i = L >> 8, c = L & 255, b = c >> 6, h8 = (c >> 3) & 7, pp = c & 7, hh = i * 8 + h8;
                const size_t qoff = (size_t)b * SEQ * 3072 + hh * 192, voff = (size_t)b * SEQ * 2048 + hh * 128, rb = (size_t)b * SEQ;
                for (int pass = 0; pass < 2; ++pass) {
                    const int qb = pass ? pp : 15 - pp;
#ifndef NO_MLA
                    attn_unit<2>((LAS char*)lds, Q1 + qoff, 3072, K1 + voff, 2048, V1 + voff, 2048, AO1 + voff, 2048, nullptr, qb, C2,
                                 p.mla_q_g, p.mla_k_g, KSS1 + rb * 16 + hh, 16, SSPE + rb, p.pos + rb, KPR + rb * 64, pass == 0);
#endif
                }
            }
        } else {
            if (step == 1) {
                if (bx < 32) {
                    const float* src = LF + (size_t)bx * SEQ; float* dst = F2 + (size_t)bx * SEQ;
                    const f32x4 a = *(const f32x4*)(src + tid * 8), b = *(const f32x4*)(src + tid * 8 + 4);
                    float v[8] = {a[0], a[1], a[2], a[3], b[0], b[1], b[2], b[3]};
#pragma unroll
                    for (int e = 1; e < 8; ++e) v[e] += v[e - 1];
                    const float total = v[7]; float incl = total;
#pragma unroll
                    for (int o = 1; o < 64; o <<= 1) { const float t = __shfl_up(incl, o); if (lane >= o) incl += t; }
                    LAS float* wt = (LAS float*)lds;
                    if (lane == 63) wt[wave] = incl;
                    __syncthreads();
                    float base = incl - total;
                    for (int w = 0; w < wave; ++w) base += wt[w];
                    f32x4 oa = {v[0] + base, v[1] + base, v[2] + base, v[3] + base}, ob = {v[4] + base, v[5] + base, v[6] + base, v[7] + base};
                    *(f32x4*)(dst + tid * 8) = oa; *(f32x4*)(dst + tid * 8 + 4) = ob;
                }
                __syncthreads();
            }
            if (step == 8) {
                for (int idx = bx * 512 + tid; idx < M * 32; idx += G * 512) {
                    const int m = idx >> 5, i = idx & 31;
                    const float a = KPE[(size_t)m * 64 + i], b = KPE[(size_t)m * 64 + 32 + i];
                    float ss = a * a + b * b;
                    ss += __shfl_xor(ss, 16); ss += __shfl_xor(ss, 8); ss += __shfl_xor(ss, 4); ss += __shfl_xor(ss, 2); ss += __shfl_xor(ss, 1);
                    if (i == 0) SSPE[m] = ss;
                    const float ta = a * p.mla_k_g[128 + i], tb = b * p.mla_k_g[160 + i];
                    const float inv = exp2f(-(float)i * (13.287712379549449f / 32.0f));
                    const float ang = (float)p.pos[m] * inv;
                    const float kq = rintf(ang * 0.15915494309189535f);
                    float rr = fmaf(-kq, 6.28125f, ang); rr = fmaf(-kq, 1.9353071795864769e-3f, rr);
                    const float sn = __sinf(rr), cs = __cosf(rr);
                    const float o1 = ta * cs - tb * sn, o2 = tb * cs + ta * sn;
                    KPR[(size_t)m * 64 + i] = (bf16_t)(cvt_pk_bf16(o1, o1) & 0xffffu);
                    KPR[(size_t)m * 64 + 32 + i] = (bf16_t)(cvt_pk_bf16(o2, o2) & 0xffffu);
                }
            }
            pg8::Gemm g; pg8::Epi E;
            E.kind = pg8::K_PLAIN; E.last = 0; E.d0 = nullptr; E.d1 = nullptr; E.d2 = nullptr; E.ldc = 0; E.rs = RS0; E.invn = 1.0f / DM;
            E.xold = nullptr; E.xout = nullptr; E.xb = XB; E.rsn = nullptr; E.kpe = KPE; E.rsq = RSQ; E.rskv = RSKV; E.kss = (step == 1) ? KSS0 : KSS1;
            g.M = M; g.A = XB; g.Bt = nullptr; g.N = 0; g.K = DM;
            switch (step) {
                case 1:  g.A = XB; g.Bt = (const bf16_t*)(ws + WS_WIN); g.N = 6144; g.K = 2048; E.kind = pg8::K_IN; E.d0 = Q0; E.d1 = K0; E.d2 = V0; E.rs = RS0; break;
                case 4:  g.A = AO0; g.Bt = (const bf16_t*)(ws + WS_WO0); g.N = 2048; g.K = 2048; E.kind = pg8::K_RES; E.xold = p.x; E.xout = p.out; E.rsn = RS1; break;
                case 5:  g.A = XB; g.Bt = (const bf16_t*)(ws + WS_WUP0); g.N = 8192; g.K = 2048; E.kind = pg8::K_UP; E.d0 = HB; E.ldc = DFF; E.rs = RS1; break;
                case 6:  g.A = HB; g.Bt = (const bf16_t*)(ws + WS_WDN0); g.N = 2048; g.K = 8192; E.kind = pg8::K_RES; E.xold = p.out; E.xout = p.out; E.rsn = RS2; break;
                case 7:  g.A = XB; g.Bt = (const bf16_t*)(ws + WS_WMD); g.N = 1280; g.K = 2048; E.kind = pg8::K_MDOWN; E.d0 = CQ; E.d1 = CKV; E.rs = RS2; break;
                case 8:  g.A = CQ; g.Bt = (const bf16_t*)(ws + WS_WUQ); g.N = 3072; g.K = 512; E.kind = pg8::K_PLAIN; E.d0 = Q1; E.ldc = 3072; E.rs = RSQ; E.invn = 1.0f / 512.f; break;
                case 9:  g.A = CKV; g.Bt = (const bf16_t*)(ws + WS_WUKV); g.N = 4096; g.K = 512; E.kind = pg8::K_UKV; E.d0 = K1; E.d1 = V1; E.rs = RSKV; E.invn = 1.0f / 512.f; break;
                case 12: g.A = AO1; g.Bt = (const bf16_t*)(ws + WS_WO1); g.N = 2048; g.K = 2048; E.kind = pg8::K_RES; E.xold = p.out; E.xout = p.out; E.rsn = RS3; break;
                case 13: g.A = XB; g.Bt = (const bf16_t*)(ws + WS_WUP1); g.N = 8192; g.K = 2048; E.kind = pg8::K_UP; E.d0 = HB; E.ldc = DFF; E.rs = RS3; break;
                default: g.A = HB; g.Bt = (const bf16_t*)(ws + WS_WDN1); g.N = 2048; g.K = 8192; E.kind = pg8::K_RES; E.xold = p.out; E.xout = p.out; E.rsn = RS3; E.last = 1; break;
            }
            pg8::StaticOrder S; S.init(M, g.N, G, bx);
#ifndef NO_GEMM
            pg8::gemm_phase<pg8::Epi, pg8::StaticOrder>(lds, g, S, E);
#endif
        }
        }
        if (step != 8 && step != 14) xcd_barrier(xbar);
    }
}

extern "C" void kernel_launch(void* const* d_in, const int* in_sizes, int n_in, void* d_out, int out_size, void* d_ws, size_t ws_size, hipStream_t stream) {
    static int grid_blocks = 0;
    if (grid_blocks == 0) {
        if (n_in != 19 || ws_size < WS_END || out_size != M * DM) { fprintf(stderr, "kernel_launch: unexpected shapes (n_in %d, ws %zu, out %d)\n", n_in, ws_size, out_size); grid_blocks = -1; return; }
        int dev = 0, cus = 0, per_cu = 0;
        (void)hipGetDevice(&dev);
        (void)hipDeviceGetAttribute(&cus, hipDeviceAttributeMultiprocessorCount, dev);
        (void)hipFuncSetAttribute((const void*)mega_fwd, hipFuncAttributeMaxDynamicSharedMemorySize, LDS_BYTES);
        if (hipOccupancyMaxActiveBlocksPerMultiprocessor(&per_cu, (const void*)mega_fwd, 512, LDS_BYTES) != hipSuccess || per_cu < 1) per_cu = 1;
        (void)hipGetLastError();
        grid_blocks = cus * per_cu;
    }
    if (grid_blocks < 0) return;
    Params p{};
    p.x = (const float*)d_in[0]; p.pos = (const int*)d_in[1]; p.ln_mix_g = (const float*)d_in[2]; p.ln_mlp_g = (const float*)d_in[3]; p.w_in = (const float*)d_in[4];
    p.b_f = (const float*)d_in[5]; p.fox_q_g = (const float*)d_in[6]; p.fox_k_g = (const float*)d_in[7]; p.w_o0 = (const float*)d_in[8]; p.mla_w_down = (const float*)d_in[9];
    p.q_a_g = (const float*)d_in[10]; p.kv_a_g = (const float*)d_in[11]; p.w_uq = (const float*)d_in[12]; p.w_ukv = (const float*)d_in[13]; p.mla_q_g = (const float*)d_in[14];
    p.mla_k_g = (const float*)d_in[15]; p.w_o1 = (const float*)d_in[16]; p.w_up = (const float*)d_in[17]; p.w_dn = (const float*)d_in[18];
    p.out = (float*)d_out; p.ws = (unsigned char*)d_ws;
    (void)hipMemsetAsync((unsigned char*)d_ws + WS_BAR, 0, 16384, stream);
    void* args[] = {&p};
    hipError_t e = hipLaunchCooperativeKernel((const void*)mega_fwd, dim3(grid_blocks), dim3(512), args, LDS_BYTES, stream);
    if (e != hipSuccess) fprintf(stderr, "cooperative launch failed: %s (grid %d)\n", hipGetErrorString(e), grid_blocks);
}
```
